# Optimizing an MI355X kernel written in HIP

```python
import math
import jax, jax.numpy as jnp
from jax import lax
import numpy as np

D_MODEL = 1024
BATCH = 16
SEQ = 256
DEPTH = 4
DEC_BATCH = 2
DEC_SEQ = 4096
PAST_LEN = 256

GRID_W = 64
HEAD_DIM = 64
ATTN_Q_HEADS = 8
ATTN_KV_HEADS = 2
ATTN_GROUP = ATTN_Q_HEADS // ATTN_KV_HEADS
ATTN_WIDTH = ATTN_Q_HEADS * HEAD_DIM
ATTN_KV_WIDTH = ATTN_KV_HEADS * HEAD_DIM
ATTN_IN = ATTN_WIDTH + 2 * ATTN_KV_WIDTH
Q_BLOCK = 128
ROPE_THETA = 10000.0
ROPE_AXIS_DIM = HEAD_DIM // 2
RWKV_HEADS = 8
RWKV_HEAD = 64
RWKV_WIDTH = RWKV_HEADS * RWKV_HEAD
RWKV_DECAY_LORA = 64
RWKV_ICLR_LORA = 64
RWKV_GATE_LORA = 128
RWKV_IN = 3 * RWKV_WIDTH + RWKV_GATE_LORA + 2 * RWKV_DECAY_LORA + 2 * RWKV_ICLR_LORA
AB_IN = ATTN_IN + RWKV_IN
MIX_WIDTH = ATTN_WIDTH + RWKV_WIDTH
S5_WIDTH = D_MODEL
S5_GROUP_CH = 16
S5_GROUPS = S5_WIDTH // S5_GROUP_CH
S5_STATE = 64
D_FF = 2816
N_AB = (DEPTH + 1) // 2
N_C = DEPTH // 2
RMS_EPS = 1e-6
GN_EPS = 64e-5
F32 = jnp.float32

kernel_name = 'hybrid_prefix_diffusion_step'


def rms_norm(x, gain):
    x32 = x.astype(F32)
    y = x32 * lax.rsqrt(jnp.mean(x32 * x32, axis=-1, keepdims=True) + RMS_EPS)
    return y.astype(x.dtype) * gain


def swiglu(h, w1, w3, w2):
    return (jax.nn.silu(h @ w1) * (h @ w3)) @ w2


def adaln(cvec, ada_w, ada_b):
    m = jnp.einsum('bd,lde->ble', jax.nn.silu(cvec), ada_w) + ada_b
    return m.reshape(cvec.shape[0], DEPTH, 3, 3, D_MODEL)


def modulated_in(x, gain, m):
    return rms_norm(x, gain) * (1 + m[:, None, 1]) + m[:, None, 0]


def residual_out(x, y, gain, m, weight):
    return x + weight * m[:, None, 2] * rms_norm(y, gain)


def axial_rope(length):
    rows = length // GRID_W
    row = jnp.repeat(jnp.arange(rows), GRID_W).astype(F32)
    col = jnp.tile(jnp.arange(GRID_W), rows).astype(F32)
    inv = ROPE_THETA ** (-jnp.arange(ROPE_AXIS_DIM // 2, dtype=F32) * 2.0 / ROPE_AXIS_DIM)
    ar, ac = row[:, None] * inv, col[:, None] * inv
    ang = jnp.concatenate([ar, ar, ac, ac], axis=-1)
    return jnp.cos(ang), jnp.sin(ang)


def apply_rope(x, cos, sin):
    x1, x2, x3, x4 = jnp.split(x, 4, axis=-1)
    rot = jnp.concatenate([-x2, x1, -x4, x3], axis=-1)
    shape = (1, cos.shape[0]) + (1,) * (x.ndim - 3) + (HEAD_DIM,)
    y = x.astype(F32) * cos.reshape(shape) + rot.astype(F32) * sin.reshape(shape)
    return y.astype(x.dtype)


def blocked_attention(q, k, v):
    b, s = q.shape[:2]
    nb = s // Q_BLOCK
    qb = jnp.moveaxis(q.reshape(b, nb, Q_BLOCK, ATTN_KV_HEADS, ATTN_GROUP, HEAD_DIM), 1, 0)
    scale = HEAD_DIM ** -0.5

    def one_block(qblk):
        sc = jnp.einsum('bqkgd,btkd->bkgqt', qblk, k).astype(F32) * scale
        p = jax.nn.softmax(sc, axis=-1).astype(v.dtype)
        return jnp.einsum('bkgqt,btkd->bqkgd', p, v)

    o = lax.map(one_block, qb)
    return jnp.moveaxis(o, 0, 1).reshape(b, s, ATTN_WIDTH)


def attention_mixer(pa, q_gain, k_gain, rope, ctx_kv):
    b, L = pa.shape[:2]
    q, k, v = jnp.split(pa, [ATTN_WIDTH, ATTN_WIDTH + ATTN_KV_WIDTH], axis=-1)
    q = rms_norm(q.reshape(b, L, ATTN_KV_HEADS, ATTN_GROUP, HEAD_DIM), q_gain)
    k = rms_norm(k.reshape(b, L, ATTN_KV_HEADS, HEAD_DIM), k_gain)
    v = v.reshape(b, L, ATTN_KV_HEADS, HEAD_DIM)
    if ctx_kv is None:
        return blocked_attention(q, k, v), k, v
    cos, sin = rope
    qr = apply_rope(q, cos, sin)
    kr = apply_rope(k, cos, sin)
    keys = jnp.concatenate([kr, ctx_kv[0]], axis=1)
    vals = jnp.concatenate([v, ctx_kv[1]], axis=1)
    return blocked_attention(qr, keys, vals), k, v


def centred_shift_mix(p, mu):
    pad = jnp.pad(p, ((0, 0), (1, 1), (0, 0)))
    nb = 0.5 * (pad[:, :-2] + pad[:, 2:])
    return p + mu * (nb - p)


def wkv_scan(r, decay, k, v, kk, a, s0, reverse):
    def step(S, inp):
        r_t, w_t, k_t, v_t, kk_t, a_t = inp
        sa = jnp.einsum('bhvk,bhk->bhv', S, -kk_t)
        S = (S * w_t[:, :, None, :] + sa[..., None] * (kk_t * a_t)[:, :, None, :]
             + v_t[..., None] * k_t[:, :, None, :])
        return S, jnp.einsum('bhvk,bhk->bhv', S, r_t)

    xs = tuple(jnp.moveaxis(t, 1, 0) for t in (r, decay, k, v, kk, a))
    s_final, y = lax.scan(step, s0, xs, reverse=reverse)
    return jnp.moveaxis(y, 0, 1), s_final


def rwkv_mixer(pb, mu, w0, w_up, a0, a_up, g_up, k_k, k_a, r_k, ln_w, ln_b, s0):
    b, L = pb.shape[:2]
    pb = centred_shift_mix(pb, mu)
    sizes = [RWKV_WIDTH, RWKV_WIDTH, RWKV_WIDTH, RWKV_GATE_LORA,
             RWKV_DECAY_LORA, RWKV_DECAY_LORA, RWKV_ICLR_LORA]
    offs = np.cumsum(sizes).tolist()
    r, k, v, g_d, wd_f, wd_b, ad_f, ad_b = jnp.split(pb, offs, axis=-1)
    g = jax.nn.sigmoid(g_d) @ g_up

    def heads(t):
        return t.reshape(b, L, RWKV_HEADS, RWKV_HEAD).astype(F32)

    r32, k32, v32 = heads(r), heads(k), heads(v)
    kk = heads(k * k_k)
    kk = kk / jnp.maximum(jnp.sqrt(jnp.sum(kk * kk, axis=-1, keepdims=True)), 1e-12)
    k_a_h = k_a.reshape(RWKV_HEADS, RWKV_HEAD).astype(F32)
    r_k32 = r_k.astype(F32)
    s0 = s0.astype(F32)
    outs, finals = [], []
    for d, (wd, ad) in enumerate(((wd_f, ad_f), (wd_b, ad_b))):
        w = -jax.nn.softplus(-(w0[d] + jnp.tanh(wd) @ w_up[d]).astype(F32)) - 0.5
        decay = jnp.exp(-jnp.exp(heads(w)))
        a = jax.nn.sigmoid(heads(a0[d] + ad @ a_up[d]))
        kd = k32 * (1 + (a - 1) * k_a_h)
        yd, sd = wkv_scan(r32, decay, kd, v32, kk, a, s0[:, d], reverse=(d == 1))
        bonus = jnp.sum(r32 * kd * r_k32, axis=-1, keepdims=True) * v32
        outs.append(yd + bonus)
        finals.append(sd)
    y = outs[0] + outs[1]
    mean = jnp.mean(y, axis=-1, keepdims=True)
    var = jnp.mean(jnp.square(y - mean), axis=-1, keepdims=True)
    y = ((y - mean) * lax.rsqrt(var + GN_EPS)).reshape(b, L, RWKV_WIDTH).astype(pb.dtype)
    y = y * ln_w + ln_b
    return y * g, jnp.stack(finals, axis=1)


def s5_combine(e1, e2):
    a1r, a1i, b1r, b1i = e1
    a2r, a2i, b2r, b2i = e2
    return (a2r * a1r - a2i * a1i, a2r * a1i + a2i * a1r,
            a2r * b1r - a2i * b1i + b2r, a2r * b1i + a2i * b1r + b2i)


def s5_mixer(u, lam_re, lam_im, log_dt, b_re, b_im, c_re, c_im, d_skip, s0):
    bsz, L = u.shape[:2]
    ug = u.reshape(bsz, L, S5_GROUPS, S5_GROUP_CH).astype(F32)
    s0 = s0.astype(F32)
    ys, finals = [], []
    for d in range(2):
        lr, li = lam_re[d].astype(F32), lam_im[d].astype(F32)
        dt = jnp.exp(log_dt[d].astype(F32))[:, None]
        mag = jnp.exp(lr * dt)
        abr, abi = mag * jnp.cos(li * dt), mag * jnp.sin(li * dt)
        den = lr * lr + li * li
        fr = ((abr - 1) * lr + abi * li) / den
        fi = (abi * lr - (abr - 1) * li) / den
        br, bi = b_re[d].astype(F32), b_im[d].astype(F32)
        bbr = fr[..., None] * br - fi[..., None] * bi
        bbi = fr[..., None] * bi + fi[..., None] * br
        bur = jnp.einsum('blgc,gnc->blgn', ug, bbr)
        bui = jnp.einsum('blgc,gnc->blgn', ug, bbi)
        sr, si = s0[:, d, 0], s0[:, d, 1]
        first = 0 if d == 0 else L - 1
        bur = bur.at[:, first].add(abr * sr - abi * si)
        bui = bui.at[:, first].add(abr * si + abi * sr)
        ar = jnp.broadcast_to(abr, bur.shape)
        ai = jnp.broadcast_to(abi, bui.shape)
        _, _, hr, hi = lax.associative_scan(s5_combine, (ar, ai, bur, bui), reverse=(d == 1), axis=1)
        ys.append(jnp.einsum('blgn,gcn->blgc', hr, c_re[d].astype(F32))
                  - jnp.einsum('blgn,gcn->blgc', hi, c_im[d].astype(F32)))
        last = L - 1 if d == 0 else 0
        finals.append(jnp.stack([hr[:, last], hi[:, last]], axis=1))
    y = (ys[0] + ys[1]).reshape(bsz, L, S5_WIDTH) + d_skip.astype(F32) * u.astype(F32)
    return y.astype(u.dtype), jnp.stack(finals, axis=1)


def run_trunk(x, mods, P, ctx):
    b, L = x.shape[:2]
    rope = None if ctx is None else axial_rope(L)
    ks, vs, rws, s5s = [], [], [], []
    for l in range(DEPTH):
        m = mods[:, l]
        i = l // 2
        h = modulated_in(x, P['norm_pre'][l, 0], m[:, 0])
        f = swiglu(h, P['ffn_w1'][l, 0], P['ffn_w3'][l, 0], P['ffn_w2'][l, 0])
        x = residual_out(x, f, P['norm_post'][l, 0], m[:, 0], 0.5)
        h = modulated_in(x, P['norm_pre'][l, 1], m[:, 1])
        if l % 2 == 0:
            p = h @ P['ab_w_in'][i]
            pa, pb = p[..., :ATTN_IN], p[..., ATTN_IN:]
            if ctx is None:
                ckv = None
                s0 = jnp.zeros((b, 2, RWKV_HEADS, RWKV_HEAD, RWKV_HEAD), F32)
            else:
                ckv = (ctx[0][:, i], ctx[1][:, i])
                s0 = ctx[2][:, i]
            oa, k_c, v_c = attention_mixer(pa, P['attn_q_gain'][i], P['attn_k_gain'][i], rope, ckv)
            ob, s_fin = rwkv_mixer(pb, P['rwkv_mu'][i], P['rwkv_w0'][i], P['rwkv_w_up'][i],
                                   P['rwkv_a0'][i], P['rwkv_a_up'][i], P['rwkv_g_up'][i],
                                   P['rwkv_k_k'][i], P['rwkv_k_a'][i], P['rwkv_r_k'][i],
                                   P['rwkv_ln_w'][i], P['rwkv_ln_b'][i], s0)
            y = jnp.concatenate([oa, ob], axis=-1) @ P['ab_w_out'][i]
            if ctx is None:
                ks.append(k_c)
                vs.append(v_c)
                rws.append(s_fin)
        else:
            u = h @ P['s5_w_in'][i]
            if ctx is None:
                s0 = jnp.zeros((b, 2, 2, S5_GROUPS, S5_STATE), F32)
            else:
                s0 = ctx[3][:, i]
            ys, s_fin = s5_mixer(u, P['s5_lambda_re'][i], P['s5_lambda_im'][i], P['s5_log_dt'][i],
                                 P['s5_b_re'][i], P['s5_b_im'][i], P['s5_c_re'][i], P['s5_c_im'][i],
                                 P['s5_d'][i], s0)
            z = jax.nn.gelu(ys)
            z = z * jax.nn.sigmoid(z @ P['s5_w_glu'][i])
            y = z @ P['s5_w_out'][i]
            if ctx is None:
                s5s.append(s_fin)
        x = residual_out(x, y, P['norm_post'][l, 1], m[:, 1], 1.0)
        h = modulated_in(x, P['norm_pre'][l, 2], m[:, 2])
        f = swiglu(h, P['ffn_w1'][l, 1], P['ffn_w3'][l, 1], P['ffn_w2'][l, 1])
        x = residual_out(x, f, P['norm_post'][l, 2], m[:, 2], 0.5)
    if ctx is None:
        return x, (jnp.stack(ks, 1), jnp.stack(vs, 1), jnp.stack(rws, 1), jnp.stack(s5s, 1))
    return x, None


def setup_inputs(seed: int = 0) -> dict:
    key = jax.random.key(seed)
    ks = iter(jax.random.split(key, 64))

    def nrm(shape, s):
        return jax.random.normal(next(ks), shape, F32) * s

    def unif(shape, lo, hi):
        return jax.random.uniform(next(ks), shape, F32, lo, hi)

    D, E, F, G, N, C16 = D_MODEL, S5_WIDTH, D_FF, S5_GROUPS, S5_STATE, S5_GROUP_CH
    lam_im = jnp.pi * jnp.broadcast_to(jnp.arange(N, dtype=F32), (N_C, 2, G, N)) + nrm((N_C, 2, G, N), 0.01)
    return {
        'x_prompt': nrm((BATCH, SEQ, D), 1.0),
        'x_sample': nrm((DEC_BATCH, DEC_SEQ, D), 1.0),
        'cache_k': nrm((DEC_BATCH, N_AB, PAST_LEN, ATTN_KV_HEADS, HEAD_DIM), 1.0),
        'cache_v': nrm((DEC_BATCH, N_AB, PAST_LEN, ATTN_KV_HEADS, HEAD_DIM), 0.6),
        'state_rwkv': nrm((DEC_BATCH, N_AB, 2, RWKV_HEADS, RWKV_HEAD, RWKV_HEAD), 0.3),
        'state_s5': nrm((DEC_BATCH, N_C, 2, 2, G, N), 0.1),
        'c': nrm((DEC_BATCH, D), 1.0),
        'c_ctx': nrm((D,), 1.0),
        'ada_w': nrm((DEPTH, D, 9 * D), 0.5 * D ** -0.5),
        'ada_b': nrm((DEPTH, 9 * D), 0.02),
        'norm_pre': 1.0 + nrm((DEPTH, 3, D), 0.02),
        'norm_post': 1.0 + nrm((DEPTH, 3, D), 0.02),
        'ffn_w1': nrm((DEPTH, 2, D, F), D ** -0.5),
        'ffn_w3': nrm((DEPTH, 2, D, F), D ** -0.5),
        'ffn_w2': nrm((DEPTH, 2, F, D), F ** -0.5),
        'ab_w_in': nrm((N_AB, D, AB_IN), D ** -0.5),
        'ab_w_out': nrm((N_AB, MIX_WIDTH, D), MIX_WIDTH ** -0.5),
        'attn_q_gain': 1.0 + nrm((N_AB, HEAD_DIM), 0.02),
        'attn_k_gain': 1.0 + nrm((N_AB, HEAD_DIM), 0.02),
        'rwkv_mu': unif((N_AB, RWKV_IN), 0.0, 1.0),
        'rwkv_w0': unif((N_AB, 2, RWKV_WIDTH), -5.0, 0.0),
        'rwkv_w_up': nrm((N_AB, 2, RWKV_DECAY_LORA, RWKV_WIDTH), 0.5 * RWKV_DECAY_LORA ** -0.5),
        'rwkv_a0': nrm((N_AB, 2, RWKV_WIDTH), 0.1),
        'rwkv_a_up': nrm((N_AB, 2, RWKV_ICLR_LORA, RWKV_WIDTH), 0.5 * RWKV_ICLR_LORA ** -0.5),
        'rwkv_g_up': nrm((N_AB, RWKV_GATE_LORA, RWKV_WIDTH), RWKV_GATE_LORA ** -0.5),
        'rwkv_k_k': 0.85 + nrm((N_AB, RWKV_WIDTH), 0.02),
        'rwkv_k_a': 1.0 + nrm((N_AB, RWKV_WIDTH), 0.02),
        'rwkv_r_k': nrm((N_AB, RWKV_HEADS, RWKV_HEAD), 0.1),
        'rwkv_ln_w': 1.0 + nrm((N_AB, RWKV_WIDTH), 0.02),
        'rwkv_ln_b': nrm((N_AB, RWKV_WIDTH), 0.02),
        's5_w_in': nrm((N_C, D, E), D ** -0.5),
        's5_lambda_re': -0.5 + nrm((N_C, 2, G, N), 0.01),
        's5_lambda_im': lam_im,
        's5_log_dt': unif((N_C, 2, G), math.log(0.001), math.log(0.1)),
        's5_b_re': nrm((N_C, 2, G, N, C16), (2 * C16) ** -0.5),
        's5_b_im': nrm((N_C, 2, G, N, C16), (2 * C16) ** -0.5),
        's5_c_re': nrm((N_C, 2, G, C16, N), (2 * N) ** -0.5),
        's5_c_im': nrm((N_C, 2, G, C16, N), (2 * N) ** -0.5),
        's5_d': nrm((N_C, E), 1.0),
        's5_w_glu': nrm((N_C, E, E), E ** -0.5),
        's5_w_out': nrm((N_C, E, D), E ** -0.5),
    }


def reference(x_prompt, x_sample, cache_k, cache_v, state_rwkv, state_s5, c, c_ctx,
              ada_w, ada_b, norm_pre, norm_post, ffn_w1, ffn_w3, ffn_w2,
              ab_w_in, ab_w_out, attn_q_gain, attn_k_gain,
              rwkv_mu, rwkv_w0, rwkv_w_up, rwkv_a0, rwkv_a_up, rwkv_g_up,
              rwkv_k_k, rwkv_k_a, rwkv_r_k, rwkv_ln_w, rwkv_ln_b,
              s5_w_in, s5_lambda_re, s5_lambda_im, s5_log_dt, s5_b_re, s5_b_im,
              s5_c_re, s5_c_im, s5_d, s5_w_glu, s5_w_out):
    P = dict(norm_pre=norm_pre, norm_post=norm_post, ffn_w1=ffn_w1, ffn_w3=ffn_w3, ffn_w2=ffn_w2,
             ab_w_in=ab_w_in, ab_w_out=ab_w_out, attn_q_gain=attn_q_gain, attn_k_gain=attn_k_gain,
             rwkv_mu=rwkv_mu, rwkv_w0=rwkv_w0, rwkv_w_up=rwkv_w_up, rwkv_a0=rwkv_a0,
             rwkv_a_up=rwkv_a_up, rwkv_g_up=rwkv_g_up, rwkv_k_k=rwkv_k_k, rwkv_k_a=rwkv_k_a,
             rwkv_r_k=rwkv_r_k, rwkv_ln_w=rwkv_ln_w, rwkv_ln_b=rwkv_ln_b,
             s5_w_in=s5_w_in, s5_lambda_re=s5_lambda_re, s5_lambda_im=s5_lambda_im,
             s5_log_dt=s5_log_dt, s5_b_re=s5_b_re, s5_b_im=s5_b_im, s5_c_re=s5_c_re,
             s5_c_im=s5_c_im, s5_d=s5_d, s5_w_glu=s5_w_glu, s5_w_out=s5_w_out)
    mods_ctx = adaln(c_ctx[None], ada_w, ada_b)
    mods_lat = adaln(c, ada_w, ada_b)
    y_prompt, ctx_out = run_trunk(x_prompt, mods_ctx, P, None)
    new_k, new_v, new_rwkv, new_s5 = ctx_out
    y_sample, _ = run_trunk(x_sample, mods_lat, P, (cache_k, cache_v, state_rwkv, state_s5))
    return (y_prompt, y_sample, new_k, new_v, new_rwkv, new_s5)
```

```cpp
#include <hip/hip_runtime.h>
#include <hip/hip_cooperative_groups.h>
#include <stdint.h>
#include <cstdio>
namespace cg = cooperative_groups;

#ifndef COOP
#define COOP 1
#endif

typedef unsigned short bf16_t;
typedef short bf16x8 __attribute__((ext_vector_type(8)));
typedef float f32x16 __attribute__((ext_vector_type(16)));
typedef float f32x4 __attribute__((ext_vector_type(4)));
typedef float f32x2 __attribute__((ext_vector_type(2)));
typedef unsigned u32x4 __attribute__((ext_vector_type(4)));
typedef unsigned u32x2 __attribute__((ext_vector_type(2)));
typedef __bf16 bf2_t __attribute__((ext_vector_type(2)));
#define DI __device__ __forceinline__

constexpr int NTOK = 12288;
constexpr size_t SZ512 = (size_t)NTOK * 512;
constexpr int NPHASE = 52;
constexpr int HALF_LDS = 60416;
constexpr int SMEM_BYTES = 2 * HALF_LDS;
constexpr float RMS_EPS = 1e-6f;
constexpr float QSCALE = 0.125f * 1.4426950408889634f;

constexpr size_t OUT_NEWK = 12582912, OUT_NEWV = 13631488, OUT_RWKV = 14680064, OUT_S5 = 16777216;

struct Params {
  const float *x_prompt, *x_sample, *cache_k, *cache_v, *state_rwkv, *state_s5, *c, *c_ctx, *ada_w, *ada_b, *norm_pre, *norm_post,
      *ffn_w1, *ffn_w3, *ffn_w2, *ab_w_in, *ab_w_out, *q_gain, *k_gain, *mu, *w0, *w_up, *a0, *a_up, *g_up, *k_k, *k_a, *r_k, *ln_w, *ln_b,
      *s5_w_in, *lam_re, *lam_im, *log_dt, *b_re, *b_im, *c_re, *c_im, *s5_d, *s5_w_glu, *s5_w_out;
  float* out;
  bf16_t *w13t, *w2t, *abint, *aboutt, *s5int, *s5glut, *s5outt, *wupt, *aupt, *gupt;
  float *mod, *rope, *s5ab;
  bf16_t *s5bbt, *s5cmt;
  unsigned* cnt;
  unsigned* xbar;
  bf16_t* hb;
  float* y;
  bf16_t* g;
  float* pw;
  bf16_t *qb, *kbc, *kbl, *vtc, *vtl;
  float *r, *kk, *v, *kraw;
  bf16_t* la;
  float* gt;
  float *u, *ysd;
  bf16_t *zb, *z2b;
};

DI unsigned pack2(float lo, float hi) {
  f32x2 v; v.x = lo; v.y = hi;
  bf2_t b = __builtin_convertvector(v, bf2_t);
  return __builtin_bit_cast(unsigned, b);
}
DI bf16_t f2bf(float x) { return (bf16_t)(pack2(x, 0.f) & 0xffffu); }
DI float bf2f(bf16_t h) { return __uint_as_float(((unsigned)h) << 16); }
DI float sigmoidf_(float x) { return 1.f / (1.f + __expf(-x)); }
DI float allred16(float x);
DI float wave_sum(float v) {
  v = allred16(v);
  v += __shfl_xor(v, 16);
  v += __shfl_xor(v, 32);
  return v;
}
DI float allred16(float x) {
  x += __int_as_float(__builtin_amdgcn_update_dpp(0, __float_as_int(x), 0xB1, 0xF, 0xF, true));
  x += __int_as_float(__builtin_amdgcn_update_dpp(0, __float_as_int(x), 0x4E, 0xF, 0xF, true));
  x += __int_as_float(__builtin_amdgcn_update_dpp(0, __float_as_int(x), 0x141, 0xF, 0xF, true));
  x += __int_as_float(__builtin_amdgcn_update_dpp(0, __float_as_int(x), 0x140, 0xF, 0xF, true));
  return x;
}
DI int vperm(int t) { const int k = t & 15; return (t & ~15) | (8 * ((k >> 2) & 1) + 4 * (k >> 3) + (k & 3)); }

DI void dsincos(double x, double& s, double& c) {
  const double k = rint(x * 0.15915494309189533576888);
  double r = fma(-k, 6.28318530717958623200e+00, x);
  r = fma(-k, 2.44929359829470635445e-16, r);
  const double r2 = r * r;
  double ts = r, tc = 1.0;
  s = r; c = 1.0;
#pragma unroll
  for (int n = 1; n <= 16; ++n) {
    tc *= -r2 * (1.0 / (double)((2 * n - 1) * (2 * n)));
    ts *= -r2 * (1.0 / (double)((2 * n) * (2 * n + 1)));
    c += tc; s += ts;
  }
}

DI void conv_tile(const int tid0, const float* __restrict__ src, bf16_t* __restrict__ dst, int K, int N, int kt, int nt, int mode, float* sm) {
  const int tid = tid0;
  const int k0 = kt * 64, n0 = nt * 64;
#pragma unroll
  for (int j = 0; j < 4; ++j) {
    const int row = (tid >> 4) + 16 * j;
    const float4 v = *(const float4*)(src + (size_t)(k0 + row) * N + n0 + (tid & 15) * 4);
    float* d = sm + row * 65 + (tid & 15) * 4;
    d[0] = v.x; d[1] = v.y; d[2] = v.z; d[3] = v.w;
  }
  __syncthreads();
  const int n = tid >> 2, kq = tid & 3;
  unsigned w[8];
#pragma unroll
  for (int j = 0; j < 8; ++j) w[j] = pack2(sm[(kq * 16 + 2 * j) * 65 + n], sm[(kq * 16 + 2 * j + 1) * 65 + n]);
  const int ng = n0 + n;
  int drow = ng;
  if (mode == 1) drow = 64 * (ng >> 5) + (ng & 31);
  else if (mode == 2) drow = 64 * (ng >> 5) + 32 + (ng & 31);
  uint4* dp = (uint4*)(dst + (size_t)drow * K + k0 + kq * 16);
  dp[0] = make_uint4(w[0], w[1], w[2], w[3]);
  dp[1] = make_uint4(w[4], w[5], w[6], w[7]);
  __syncthreads();
}

DI void conv_by_T(const int tid0, const Params& p, int T, float* sm) {
      const float* src; bf16_t* dst; int K, N, kt, nt, mode = 0;
      if (T < 5632) { const int m = T / 704, r = T % 704; kt = r / 44; nt = r % 44; K = 1024; N = 2816; src = p.ffn_w1 + (size_t)m * 1024 * 2816; dst = p.w13t + (size_t)m * 5632 * 1024; mode = 1; }
      else if (T < 11264) { T -= 5632; const int m = T / 704, r = T % 704; kt = r / 44; nt = r % 44; K = 1024; N = 2816; src = p.ffn_w3 + (size_t)m * 1024 * 2816; dst = p.w13t + (size_t)m * 5632 * 1024; mode = 2; }
      else if (T < 16896) { T -= 11264; const int m = T / 704, r = T % 704; kt = r / 16; nt = r % 16; K = 2816; N = 1024; src = p.ffn_w2 + (size_t)m * 2816 * 1024; dst = p.w2t + (size_t)m * 1024 * 2816; }
      else if (T < 18240) { T -= 16896; const int m = T / 672, r = T % 672; kt = r / 42; nt = r % 42; K = 1024; N = 2688; src = p.ab_w_in + (size_t)m * 1024 * 2688; dst = p.abint + (size_t)m * 2816 * 1024; }
      else if (T < 20288) {
        T -= 18240; const int grp = T / 512; T %= 512;
        const int m = T / 256, r = T % 256; kt = r / 16; nt = r % 16; K = 1024; N = 1024;
        const float* s0 = grp == 0 ? p.ab_w_out : grp == 1 ? p.s5_w_in : grp == 2 ? p.s5_w_glu : p.s5_w_out;
        bf16_t* d0 = grp == 0 ? p.aboutt : grp == 1 ? p.s5int : grp == 2 ? p.s5glut : p.s5outt;
        src = s0 + (size_t)m * 1048576; dst = d0 + (size_t)m * 1048576;
      }
      else if (T < 20320) { T -= 20288; const int m = T / 8; kt = 0; nt = T % 8; K = 64; N = 512; src = p.w_up + (size_t)m * 32768; dst = p.wupt + (size_t)m * 32768; }
      else if (T < 20352) { T -= 20320; const int m = T / 8; kt = 0; nt = T % 8; K = 64; N = 512; src = p.a_up + (size_t)m * 32768; dst = p.aupt + (size_t)m * 32768; }
      else { T -= 20352; const int m = T / 16, r = T % 16; kt = r / 8; nt = r % 8; K = 128; N = 512; src = p.g_up + (size_t)m * 65536; dst = p.gupt + (size_t)m * 65536; }
      conv_tile(tid0, src, dst, K, N, kt, nt, mode, sm);
}

constexpr int N_CONV_EARLY = 4944;
DI int conv_early_T(int e) {
  if (e < 1408) return e;
  if (e < 2816) return 5632 + (e - 1408);
  if (e < 4224) return 11264 + (e - 2816);
  if (e < 4896) return 16896 + (e - 4224);
  if (e < 4912) return 20288 + (e - 4896);
  if (e < 4928) return 20320 + (e - 4912);
  return 20352 + (e - 4928);
}
constexpr int N_CONV_LATE_A = 8080, N_CONV_LATE_B = 7360;
DI int conv_lateA_T(int q) {
  if (q < 6336) return (q / 2112) * 5632 + 1408 + (q % 2112);
  if (q < 7008) return 16896 + 672 + (q - 6336);
  if (q < 8032) { const int r = q - 7008; return 18240 + (r >> 8) * 512 + (r & 255); }
  const int r = q - 8032;
  if (r < 16) return 20288 + 16 + r;
  if (r < 32) return 20320 + 16 + (r - 16);
  return 20352 + 16 + (r - 32);
}
DI int conv_lateB_T(int q) {
  if (q < 6336) return (q / 2112) * 5632 + 3520 + (q % 2112);
  const int r = q - 6336;
  return 18240 + (r >> 8) * 512 + 256 + (r & 255);
}

DI void init_phase(const int tid0, const int vb, const int vg, const Params& p, char* smem) {
  float* sm = (float*)smem;
  const int tid = tid0;
  constexpr int N_MOD = 576, N_S5 = 64, N_MISC = 2, N_CONV = N_CONV_EARLY;
  constexpr int TOTAL = N_MOD + N_S5 + N_MISC + N_CONV;
  for (int it = vb; it < TOTAL; it += vg) {
    if (it < N_MOD) {
      const int l = it / 144, eb = it % 144, e0 = eb * 64;
      for (int idx = tid; idx < 3072; idx += 256) {
        const int set = idx >> 10, d = idx & 1023;
        const float cv = (set == 0) ? p.c_ctx[d] : p.c[(set - 1) * 1024 + d];
        sm[idx] = cv * sigmoidf_(cv);
      }
      __syncthreads();
      const int cq = tid & 15, dg = tid >> 4;
      float acc[3][4];
#pragma unroll
      for (int s = 0; s < 3; ++s)
#pragma unroll
        for (int e = 0; e < 4; ++e) acc[s][e] = 0.f;
      const float* wp = p.ada_w + ((size_t)l * 1024 + dg * 64) * 9216 + e0 + cq * 4;
#pragma unroll 8
      for (int dd = 0; dd < 64; ++dd) {
        const float4 w = *(const float4*)(wp + (size_t)dd * 9216);
        const int d = dg * 64 + dd;
#pragma unroll
        for (int s = 0; s < 3; ++s) {
          const float sv = sm[s * 1024 + d];
          acc[s][0] += sv * w.x; acc[s][1] += sv * w.y; acc[s][2] += sv * w.z; acc[s][3] += sv * w.w;
        }
      }
      float* red = sm + 3072;
#pragma unroll
      for (int s = 0; s < 3; ++s)
#pragma unroll
        for (int e = 0; e < 4; ++e) red[(dg * 3 + s) * 64 + cq * 4 + e] = acc[s][e];
      __syncthreads();
      if (tid < 192) {
        const int set = tid >> 6, col = tid & 63;
        float sum = p.ada_b[l * 9216 + e0 + col];
#pragma unroll
        for (int g = 0; g < 16; ++g) sum += red[(g * 3 + set) * 64 + col];
        p.mod[((size_t)set * 4 + l) * 9216 + e0 + col] = sum;
      }
      __syncthreads();
    } else if (it < N_MOD + N_S5) {
      const int idx = (it - N_MOD) * 256 + tid;
      const int id = idx >> 12, g = (idx >> 6) & 63, n = idx & 63;
      const double lr = p.lam_re[idx], li = p.lam_im[idx];
      const double dt = exp((double)p.log_dt[id * 64 + g]);
      const double mag = exp(lr * dt);
      double sn, cs;
      dsincos(li * dt, sn, cs);
      const double abr = mag * cs, abi = mag * sn;
      const double den = lr * lr + li * li;
      const double fr = ((abr - 1.0) * lr + abi * li) / den;
      const double fi = (abi * lr - (abr - 1.0) * li) / den;
      p.s5ab[idx * 2] = (float)abr;
      p.s5ab[idx * 2 + 1] = (float)abi;
      bf16_t* bb = p.s5bbt + (size_t)(id * 64 + g) * 2048;
      bf16_t* cm = p.s5cmt + (size_t)(id * 64 + g) * 2048;
#pragma unroll
      for (int c = 0; c < 16; ++c) {
        const double br = p.b_re[(size_t)idx * 16 + c], bi = p.b_im[(size_t)idx * 16 + c];
        bb[n * 16 + c] = f2bf((float)(fr * br - fi * bi));
        bb[(64 + n) * 16 + c] = f2bf((float)(fr * bi + fi * br));
        const size_t ci = ((size_t)(id * 64 + g) * 16 + c) * 64 + n;
        cm[c * 128 + 2 * n] = f2bf(p.c_re[ci]);
        cm[c * 128 + 2 * n + 1] = f2bf(-p.c_im[ci]);
      }
    } else if (it < N_MOD + N_S5 + N_MISC) {
      if (it == N_MOD + N_S5 + 1) {
        for (int m = 0; m < 2; ++m) {
          uint4* z = (uint4*)(p.abint + ((size_t)m * 2816 + 2688) * 1024);
#pragma unroll 1
          for (int e = tid; e < 128 * 1024 / 8; e += 256) z[e] = make_uint4(0u, 0u, 0u, 0u);
        }
      } else
      for (int idx = tid; idx < 1024; idx += 256) {
        const int pos = idx >> 4, j = idx & 15;
        const double inv = exp(-(double)j * (9.210340371976184 / 16.0));
        double sn, cs;
        dsincos((double)pos * inv, sn, cs);
        p.rope[idx * 2] = (float)cs;
        p.rope[idx * 2 + 1] = (float)sn;
      }
      if (it == N_MOD + N_S5 && tid < 64) p.cnt[tid] = 0u;
    } else {
      conv_by_T(tid0, p, conv_early_T(it - (N_MOD + N_S5 + N_MISC)), sm);
    }
  }
}

DI void row_phase(const int tid0, const int vb, const int vg, const Params& p, int l, int sub, bool has_prev, bool has_next) {
  const int lane = tid0 & 63, wave = tid0 >> 6;
  int lp = l, sp = sub - 1;
  if (sub == 0) { lp = l - 1; sp = 2; }
  if (lp < 0) { lp = 0; sp = 0; }
  const int ln = has_next ? l : 0;
  const float wgt = (sp == 1) ? 1.0f : 0.5f;
  const int co = lane * 4;
  for (int rb = vb; rb < NTOK / 8; rb += vg) {
    const int row0 = rb * 8 + wave;
    const int set = row0 < 4096 ? 0 : 1 + ((row0 - 4096) >> 12);
    const float* gp = p.norm_post + (size_t)(lp * 3 + sp) * 1024;
    const float* gt = p.mod + (((size_t)set * 4 + lp) * 9 + sp * 3 + 2) * 1024;
    const float* pre = p.norm_pre + (size_t)(ln * 3 + sub) * 1024;
    const float* sh = p.mod + (((size_t)set * 4 + ln) * 9 + sub * 3 + 0) * 1024;
    f32x4 x[2][4], gpv[4], gtv[4], prv[4], shv[4], scv[4];
    uint2 yb[2][4];
#pragma unroll
    for (int q = 0; q < 2; ++q) {
      const int row = row0 + 4 * q;
      const float* xs = has_prev ? p.out + (size_t)row * 1024 : (row < 4096 ? p.x_prompt + (size_t)row * 1024 : p.x_sample + (size_t)(row - 4096) * 1024);
      const bf16_t* yr = (const bf16_t*)p.y + (size_t)row * 1024;
#pragma unroll
      for (int j = 0; j < 4; ++j) {
        x[q][j] = *(const f32x4*)(xs + j * 256 + co);
        if (has_prev) yb[q][j] = *(const uint2*)(yr + j * 256 + co);
      }
    }
#pragma unroll
    for (int j = 0; j < 4; ++j) {
      if (has_prev) { gpv[j] = *(const f32x4*)(gp + j * 256 + co); gtv[j] = *(const f32x4*)(gt + j * 256 + co); }
      if (has_next) { prv[j] = *(const f32x4*)(pre + j * 256 + co); shv[j] = *(const f32x4*)(sh + j * 256 + co); scv[j] = *(const f32x4*)(sh + 1024 + j * 256 + co); }
    }
#pragma unroll
    for (int q = 0; q < 2; ++q) {
      const int row = row0 + 4 * q;
      float* xr = p.out + (size_t)row * 1024;
      if (has_prev) {
        f32x4 yv[4];
        float ss = 0.f;
#pragma unroll
        for (int j = 0; j < 4; ++j) {
          yv[j] = f32x4{__uint_as_float(yb[q][j].x << 16), __uint_as_float(yb[q][j].x & 0xffff0000u), __uint_as_float(yb[q][j].y << 16), __uint_as_float(yb[q][j].y & 0xffff0000u)};
          ss += yv[j].x * yv[j].x + yv[j].y * yv[j].y + yv[j].z * yv[j].z + yv[j].w * yv[j].w;
        }
        ss = wave_sum(ss);
        const float rs = rsqrtf(ss * (1.f / 1024.f) + RMS_EPS) * wgt;
#pragma unroll
        for (int j = 0; j < 4; ++j) x[q][j] += gtv[j] * (yv[j] * rs * gpv[j]);
      }
#pragma unroll
      for (int j = 0; j < 4; ++j) *(f32x4*)(xr + j * 256 + co) = x[q][j];
      if (has_next) {
        float ss = 0.f;
#pragma unroll
        for (int j = 0; j < 4; ++j) ss += x[q][j].x * x[q][j].x + x[q][j].y * x[q][j].y + x[q][j].z * x[q][j].z + x[q][j].w * x[q][j].w;
        ss = wave_sum(ss);
        const float rs = rsqrtf(ss * (1.f / 1024.f) + RMS_EPS);
        bf16_t* hr = p.hb + (size_t)row * 1024;
#pragma unroll
        for (int j = 0; j < 4; ++j) {
          const f32x4 hv = x[q][j] * rs * prv[j] * (1.f + scv[j]) + shv[j];
          *(uint2*)(hr + j * 256 + co) = make_uint2(pack2(hv.x, hv.y), pack2(hv.z, hv.w));
        }
      }
    }
  }
}

enum { EPI_F32 = 0, EPI_SWIGLU = 1, EPI_GLU = 2, EPI_DECAY = 3, EPI_A = 4, EPI_Y = 5 };
struct GemmDesc {
  const bf16_t* A; const bf16_t* Bt; int lda, ldb, K, epi, ldc;
  float* C; bf16_t* Cb; const float* e0; const float* e1; float* o1; float* o2; const bf16_t* zin;
};

DI void store_pair_bf16(bf16_t* __restrict__ C, const int ld, const int row_i, const int col, const int odd, const float vi, const float vi1) {
  const float send = odd ? vi : vi1;
  const float recv = __int_as_float(__builtin_amdgcn_update_dpp(0, __float_as_int(send), 0xB1, 0xF, 0xF, true));
  const float keep = odd ? vi1 : vi;
  const float lo = odd ? recv : keep, hi = odd ? keep : recv;
  *(unsigned*)(C + (unsigned)((row_i + odd) * ld + (col & ~1))) = pack2(lo, hi);
}

DI void gemm_tile(const int tid0, const GemmDesc& d, int m0, int n0, const Params& p, char* smem) {
  const int tid = tid0, lane = tid & 63, wave = tid >> 6, wm = wave >> 2, wn = wave & 3, l32 = lane & 31, hh = lane >> 5;
  f32x16 acc[3][2];
#pragma unroll
  for (int a = 0; a < 3; ++a)
#pragma unroll
    for (int b = 0; b < 2; ++b)
#pragma unroll
      for (int i = 0; i < 16; ++i) acc[a][b][i] = 0.f;
  const int lrow = tid >> 3, kc = (tid & 7) ^ ((lrow >> 1) & 7);
  const bf16_t* ag = d.A + (size_t)(m0 + lrow) * d.lda + kc * 8;
  const bf16_t* bg = d.Bt + (size_t)(n0 + lrow) * d.ldb + kc * 8;
  const size_t a64 = (size_t)64 * d.lda, b64 = (size_t)64 * d.ldb;
  const int nk = d.K >> 6;
#define GEMM_GLDS(kt_, base_) do { \
    char* wb_ = (base_) + wave * 1024; \
    _Pragma("unroll") for (int j = 0; j < 3; ++j) __builtin_amdgcn_global_load_lds((const unsigned*)(ag + j * a64 + (kt_) * 64), (unsigned*)(wb_ + j * 8192), 16, 0, 0); \
    _Pragma("unroll") for (int j = 0; j < 4; ++j) __builtin_amdgcn_global_load_lds((const unsigned*)(bg + j * b64 + (kt_) * 64), (unsigned*)(wb_ + 24576 + j * 8192), 16, 0, 0); \
  } while (0)
  GEMM_GLDS(0, smem);
  asm volatile("s_waitcnt vmcnt(0)" ::: "memory");
  __syncthreads();
  const int sx = (l32 >> 1) & 7;
  const int offA = (wm * 96 + l32) * 128, offB = 24576 + (wn * 64 + l32) * 128;
  for (int kt = 0; kt < nk; ++kt) {
    const char* st = smem + (kt & 1) * HALF_LDS;
    if (kt + 1 < nk) GEMM_GLDS(kt + 1, smem + ((kt + 1) & 1) * HALF_LDS);
    bf16x8 af[2][3], bfr[2][2];
    {
      const int pos = ((0 * 2 + hh) ^ sx) << 4;
#pragma unroll
      for (int a = 0; a < 3; ++a) af[0][a] = *(const bf16x8*)(st + offA + a * 4096 + pos);
#pragma unroll
      for (int b = 0; b < 2; ++b) bfr[0][b] = *(const bf16x8*)(st + offB + b * 4096 + pos);
    }
#pragma unroll
    for (int ks = 0; ks < 4; ++ks) {
      if (ks < 3) {
        const int pos = (((ks + 1) * 2 + hh) ^ sx) << 4;
#pragma unroll
        for (int a = 0; a < 3; ++a) af[(ks + 1) & 1][a] = *(const bf16x8*)(st + offA + a * 4096 + pos);
#pragma unroll
        for (int b = 0; b < 2; ++b) bfr[(ks + 1) & 1][b] = *(const bf16x8*)(st + offB + b * 4096 + pos);
      }
#pragma unroll
      for (int a = 0; a < 3; ++a)
#pragma unroll
        for (int b = 0; b < 2; ++b) acc[a][b] = __builtin_amdgcn_mfma_f32_32x32x16_bf16(af[ks & 1][a], bfr[ks & 1][b], acc[a][b], 0, 0, 0);
      __builtin_amdgcn_sched_barrier(0);
    }
    asm volatile("s_waitcnt vmcnt(0)" ::: "memory");
    __syncthreads();
  }
  const int rbase = m0 + wm * 96 + 4 * hh;
  const int cbase = n0 + wn * 64 + l32;
  const int odd = l32 & 1;
  if (d.epi == EPI_F32) {
    float* __restrict__ C = d.C;
#pragma unroll
    for (int a = 0; a < 3; ++a)
#pragma unroll
      for (int b = 0; b < 2; ++b)
#pragma unroll
        for (int i = 0; i < 16; ++i) {
          const int row = rbase + a * 32 + 8 * (i >> 2) + (i & 3);
          C[(unsigned)(row * d.ldc + cbase + b * 32)] = acc[a][b][i];
        }
  } else if (d.epi == EPI_Y) {
    bf16_t* __restrict__ Cb = d.Cb;
#pragma unroll
    for (int a = 0; a < 3; ++a)
#pragma unroll
      for (int b = 0; b < 2; ++b)
#pragma unroll
        for (int i = 0; i < 16; i += 2) {
          const int row = rbase + a * 32 + 8 * (i >> 2) + (i & 3);
          store_pair_bf16(Cb, 1024, row, cbase + b * 32, odd, acc[a][b][i], acc[a][b][i + 1]);
        }
  } else if (d.epi == EPI_SWIGLU) {
    bf16_t* __restrict__ Cb = d.Cb;
    const int colo = ((n0 + wn * 64) >> 1) + l32;
#pragma unroll
    for (int a = 0; a < 3; ++a)
#pragma unroll
      for (int i = 0; i < 16; i += 2) {
        const int row = rbase + a * 32 + 8 * (i >> 2) + (i & 3);
        const float a1 = acc[a][0][i], a3 = acc[a][1][i], b1 = acc[a][0][i + 1], b3 = acc[a][1][i + 1];
        const float g0 = a1 * __builtin_amdgcn_rcpf(1.f + __expf(-a1)) * a3;
        const float g1 = b1 * __builtin_amdgcn_rcpf(1.f + __expf(-b1)) * b3;
        store_pair_bf16(Cb, 2816, row, colo, odd, g0, g1);
      }
  } else if (d.epi == EPI_GLU) {
    bf16_t* __restrict__ Cb = d.Cb;
    const bf16_t* __restrict__ zin = d.zin;
#pragma unroll
    for (int a = 0; a < 3; ++a)
#pragma unroll
      for (int b = 0; b < 2; ++b)
#pragma unroll
        for (int i = 0; i < 16; i += 2) {
          if ((i & 3) == 0) __builtin_amdgcn_sched_barrier(0);
          const int row = rbase + a * 32 + 8 * (i >> 2) + (i & 3);
          const unsigned o = (unsigned)(row * 1024 + cbase + b * 32);
          const float z0 = bf2f(zin[o]) * __builtin_amdgcn_rcpf(1.f + __expf(-acc[a][b][i]));
          const float z1 = bf2f(zin[o + 1024]) * __builtin_amdgcn_rcpf(1.f + __expf(-acc[a][b][i + 1]));
          store_pair_bf16(Cb, 1024, row, cbase + b * 32, odd, z0, z1);
        }
  } else if (d.epi == EPI_DECAY) {
    float* __restrict__ C = d.C;
#pragma unroll
    for (int a = 0; a < 3; ++a)
#pragma unroll
      for (int b = 0; b < 2; ++b) {
        const float w0 = d.e0[cbase + b * 32];
#pragma unroll
        for (int i = 0; i < 16; ++i) {
          if ((i & 3) == 0) __builtin_amdgcn_sched_barrier(0);
          const int row = rbase + a * 32 + 8 * (i >> 2) + (i & 3);
          const float xx = -(w0 + acc[a][b][i]);
          const float sp = fmaxf(xx, 0.f) + __logf(1.f + __expf(-fabsf(xx)));
          const float w = -sp - 0.5f;
          C[(unsigned)(row * 512 + cbase + b * 32)] = __expf(-__expf(w));
        }
      }
  } else {
    float* __restrict__ o1 = d.o1;
    float* __restrict__ o2 = d.o2;
    const float* __restrict__ kkp = p.kk;
    const float* __restrict__ krp = p.kraw;
#pragma unroll
    for (int a = 0; a < 3; ++a)
#pragma unroll
      for (int b = 0; b < 2; ++b) {
        const float a0v = d.e0[cbase + b * 32];
        const float kav = d.e1[cbase + b * 32];
#pragma unroll
        for (int i = 0; i < 16; ++i) {
          if ((i & 3) == 0) __builtin_amdgcn_sched_barrier(0);
          const int row = rbase + a * 32 + 8 * (i >> 2) + (i & 3);
          const unsigned o = (unsigned)(row * 512 + cbase + b * 32);
          const float av = __builtin_amdgcn_rcpf(1.f + __expf(-(a0v + acc[a][b][i])));
          o1[o] = kkp[o] * av;
          o2[o] = krp[o] * (1.f + (av - 1.f) * kav);
        }
      }
  }
}

enum { G_UP = 0, G_DOWN, G_ABIN, G_ABOUT, G_S5IN, G_GLU, G_S5OUT, G_LORA };

DI void gemm_phase(const int tid0, const Params& p, int kind, int l, int j, char* smem) {
  const int i = l >> 1;
  int N;
  switch (kind) {
    case G_UP: N = 5632; break;
    case G_ABIN: N = 2816; break;
    case G_LORA: N = 2560; break;
    default: N = 1024; break;
  }
  const int ntiles = 64 * (N >> 8);
  for (int tile = blockIdx.x; tile < ntiles; tile += gridDim.x) {
    const int mt = tile & 63;
    int nt = tile >> 6;
    GemmDesc d;
    d.lda = 1024; d.ldb = 1024; d.K = 1024; d.epi = EPI_F32; d.ldc = 1024;
    d.C = nullptr; d.Cb = nullptr; d.e0 = nullptr; d.e1 = nullptr; d.o1 = nullptr; d.o2 = nullptr; d.zin = nullptr;
    d.A = p.hb; d.Bt = nullptr;
    if (kind == G_UP) { d.Bt = p.w13t + (size_t)(l * 2 + j) * 5632 * 1024; d.epi = EPI_SWIGLU; d.Cb = p.g; }
    else if (kind == G_DOWN) { d.A = p.g; d.lda = 2816; d.Bt = p.w2t + (size_t)(l * 2 + j) * 1024 * 2816; d.ldb = 2816; d.K = 2816; d.epi = EPI_Y; d.Cb = (bf16_t*)p.y; }
    else if (kind == G_ABIN) { d.Bt = p.abint + (size_t)i * 2816 * 1024; d.C = p.pw; d.ldc = 2816; }
    else if (kind == G_ABOUT) { d.Bt = p.aboutt + (size_t)i * 1048576; d.epi = EPI_Y; d.Cb = (bf16_t*)p.y; }
    else if (kind == G_S5IN) { d.Bt = p.s5int + (size_t)i * 1048576; d.C = p.u; }
    else if (kind == G_GLU) { d.A = p.zb; d.Bt = p.s5glut + (size_t)i * 1048576; d.epi = EPI_GLU; d.zin = p.zb; d.Cb = p.z2b; }
    else if (kind == G_S5OUT) { d.A = p.z2b; d.Bt = p.s5outt + (size_t)i * 1048576; d.epi = EPI_Y; d.Cb = (bf16_t*)p.y; }
    else {
      const int which = nt >> 1; nt &= 1;
      d.lda = 384; d.ldb = 64; d.K = 64; d.ldc = 512;
      if (which < 2) { d.A = p.la + which * 64; d.Bt = p.wupt + (size_t)(i * 2 + which) * 32768; d.epi = EPI_DECAY; d.e0 = p.w0 + (i * 2 + which) * 512; d.C = p.pw + (size_t)(which * 3) * SZ512; }
      else if (which < 4) { const int dd = which - 2; d.A = p.la + 128 + dd * 64; d.Bt = p.aupt + (size_t)(i * 2 + dd) * 32768; d.epi = EPI_A; d.e0 = p.a0 + (i * 2 + dd) * 512; d.e1 = p.k_a + i * 512;
                         d.o1 = p.pw + (size_t)(dd * 3 + 1) * SZ512; d.o2 = p.pw + (size_t)(dd * 3 + 2) * SZ512; }
      else { d.A = p.la + 256; d.Bt = p.gupt + (size_t)i * 65536; d.ldb = 128; d.K = 128; d.C = p.gt; }
    }
    gemm_tile(tid0, d, mt * 192, nt * 256, p, smem);
  }
}

DI void prep_phase(const int tid0, const int vb, const int vg, const Params& p, int i) {
  const int tid = tid0, lane = tid & 63, wave = tid >> 6;
  constexpr int NROWB = NTOK / 4, NCACHE = 64;
  for (int it = vb; it < NROWB + NCACHE; it += vg) {
    if (it < NROWB) {
      const int row = it * 4 + wave;
      const bool isctx = row < 4096;
      int b, t, L;
      if (isctx) { b = row >> 8; t = row & 255; L = 256; } else { b = (row - 4096) >> 12; t = (row - 4096) & 4095; L = 4096; }
      const float* pr = p.pw + (size_t)row * 2816;
      const float qg = p.q_gain[i * 64 + lane], kg = p.k_gain[i * 64 + lane];
      float cs = 1.f, sn = 0.f;
      if (!isctx) {
        const int pos = (lane < 32) ? (t >> 6) : (t & 63);
        cs = p.rope[(pos * 16 + (lane & 15)) * 2];
        sn = p.rope[(pos * 16 + (lane & 15)) * 2 + 1];
        if (!(lane & 16)) sn = -sn;
      }
      float qx[8], kx[2], vx[2];
#pragma unroll
      for (int h = 0; h < 8; ++h) qx[h] = pr[h * 64 + lane];
#pragma unroll
      for (int kv = 0; kv < 2; ++kv) { kx[kv] = pr[512 + kv * 64 + lane]; vx[kv] = pr[640 + kv * 64 + lane]; }
      const float* pb = pr + 768;
      const bool hp = t > 0, hn = t < L - 1;
      float xs[30], xps[30], xns[30];
#pragma unroll
      for (int j = 0; j < 15; ++j) {
        const int c = j * 64 + lane;
        xs[j] = pb[c];
        xps[j] = hp ? pb[c - 2816] : 0.f;
        xns[j] = hn ? pb[c + 2816] : 0.f;
      }
#pragma unroll
      for (int h = 0; h < 8; ++h) {
        const float x = qx[h];
        const float ss = wave_sum(x * x);
        float xn = x * rsqrtf(ss * (1.f / 64.f) + RMS_EPS) * qg;
        const float xp = __shfl_xor(xn, 16);
        xn = xn * cs + xp * sn;
        p.qb[(size_t)row * 512 + h * 64 + lane] = f2bf(xn * QSCALE);
      }
#pragma unroll
      for (int kv = 0; kv < 2; ++kv) {
        const float x = kx[kv];
        const float ss = wave_sum(x * x);
        const float kn = x * rsqrtf(ss * (1.f / 64.f) + RMS_EPS) * kg;
        const float xp = __shfl_xor(kn, 16);
        const float kr = kn * cs + xp * sn;
        const float vv = vx[kv];
        if (isctx) {
          const size_t o = ((size_t)(b * 2 + i) * 256 + t) * 128 + kv * 64 + lane;
          p.out[OUT_NEWK + o] = kn;
          p.out[OUT_NEWV + o] = vv;
          p.kbc[((size_t)(b * 2 + kv) * 256 + t) * 64 + lane] = f2bf(kr);
          p.vtc[((size_t)(b * 2 + kv) * 64 + lane) * 256 + vperm(t)] = f2bf(vv);
        } else {
          p.kbl[((size_t)(b * 2 + kv) * 4352 + t) * 64 + lane] = f2bf(kr);
          p.vtl[((size_t)(b * 2 + kv) * 64 + lane) * 4352 + vperm(t)] = f2bf(vv);
        }
      }
      const float* mu = p.mu + i * 1920;
#pragma unroll
      for (int j = 0; j < 30; ++j) {
        if (j == 3) {
#pragma unroll
          for (int jj = 15; jj < 30; ++jj) {
            const int cc = jj * 64 + lane;
            xs[jj] = pb[cc];
            xps[jj] = hp ? pb[cc - 2816] : 0.f;
            xns[jj] = hn ? pb[cc + 2816] : 0.f;
          }
        }
        const int c = j * 64 + lane;
        const float x = xs[j];
        const float xp = xps[j];
        const float xn = xns[j];
        const float m = x + mu[c] * (0.5f * (xp + xn) - x);
        if (j < 8) p.r[(size_t)row * 512 + c] = m;
        else if (j < 16) {
          const size_t o = (size_t)row * 512 + c - 512;
          p.kraw[o] = m;
          const float kkv = m * p.k_k[i * 512 + c - 512];
          const float ss = wave_sum(kkv * kkv);
          p.kk[o] = kkv / fmaxf(sqrtf(ss), 1e-12f);
        } else if (j < 24) p.v[(size_t)row * 512 + c - 1024] = m;
        else if (j < 26) p.la[(size_t)row * 384 + 256 + (c - 1536)] = f2bf(sigmoidf_(m));
        else if (j < 28) p.la[(size_t)row * 384 + (j - 26) * 64 + lane] = f2bf(1.f - 2.f / (1.f + __expf(2.f * m)));
        else p.la[(size_t)row * 384 + 128 + (j - 28) * 64 + lane] = f2bf(m);
      }
    } else {
      const int base = (it - NROWB) * 1024;
#pragma unroll
      for (int e = 0; e < 4; ++e) {
        const int idx = base + e * 256 + tid;
        const int d = idx & 63, kv = (idx >> 6) & 1, pp = (idx >> 7) & 255, b = idx >> 15;
        const size_t ci = ((((size_t)b * 2 + i) * 256 + pp) * 2 + kv) * 64 + d;
        p.kbl[((size_t)(b * 2 + kv) * 4352 + 4096 + pp) * 64 + d] = f2bf(p.cache_k[ci]);
        p.vtl[((size_t)(b * 2 + kv) * 64 + d) * 4352 + 4096 + vperm(pp)] = f2bf(p.cache_v[ci]);
      }
    }
  }
}

DI void wkv_item(const int tid0, const Params& p, int i, bool isctx, int b, int h, int dir, int qr, char* smem, const bool do_comp, const bool do_load) {
  float* buf = (float*)smem;
  float* vb = buf + 2 * 5 * 1024;
  const int tid = tid0, lane = tid & 63, wave = tid >> 6, q = lane >> 4, j = lane & 15;
  const int L = isctx ? 256 : 4096;
  const int row0 = isctx ? b * 256 : 4096 + b * 4096;
  const int vrow = qr * 16 + wave * 4 + q;
  const float* Wd = p.pw + (size_t)(dir * 3) * SZ512;
  const float* KKA = Wd + SZ512;
  const float* KD = KKA + SZ512;
  float* ys = p.y + (size_t)dir * SZ512;
  f32x2 Sa = {0.f, 0.f}, Sb = {0.f, 0.f};
  const bool solo = do_comp != do_load;
  float* ypart0 = (float*)(smem + 43008) + wave * 1024;
  const size_t sidx = ((((size_t)b * 2 + i) * 2 + dir) * 8 + h) * 4096 + vrow * 64 + j * 4;
  if (!isctx && do_comp) {
    const float4 s = *(const float4*)(p.state_rwkv + sidx);
    Sa = f32x2{s.x, s.y}; Sb = f32x2{s.z, s.w};
  }
  const int nch = L >> 4;
  const int lstep = tid >> 4, lquad = tid & 15;
  const int vstep = (tid >> 2) & 15, vq4 = tid & 3;
  auto load_chunk = [&](int ck, f32x4 (&ls)[5], f32x4& lv) {
    const int s1 = ck * 16 + lstep;
    const int t = dir ? (L - 1 - s1) : s1;
    const size_t off = (size_t)(row0 + t) * 512 + h * 64 + lquad * 4;
    ls[0] = *(const f32x4*)(Wd + off); ls[1] = *(const f32x4*)(p.kk + off); ls[2] = *(const f32x4*)(KKA + off);
    ls[3] = *(const f32x4*)(KD + off); ls[4] = *(const f32x4*)(p.r + off);
    const int s2 = ck * 16 + vstep;
    const int t2 = dir ? (L - 1 - s2) : s2;
    lv = *(const f32x4*)(p.v + (size_t)(row0 + t2) * 512 + h * 64 + qr * 16 + vq4 * 4);
  };
  auto publish_chunk = [&](int bi, const f32x4 (&ls)[5], const f32x4& lv) {
    float* bn = buf + bi * 5120;
#pragma unroll
    for (int a = 0; a < 5; ++a) *(f32x4*)(bn + a * 1024 + lstep * 64 + lquad * 4) = ls[a];
    if (tid < 64) *(f32x4*)(vb + bi * 256 + vstep * 16 + vq4 * 4) = lv;
  };
  auto reduce_y = [&](const int cc, const float* yp) {
    const float* yr = yp + j * 64 + q * 16;
    const f32x4 y0 = *(const f32x4*)(yr), y1 = *(const f32x4*)(yr + 4), y2 = *(const f32x4*)(yr + 8), y3 = *(const f32x4*)(yr + 12);
    const f32x4 ysum = (y0 + y1) + (y2 + y3);
    const float yv = (ysum.x + ysum.y) + (ysum.z + ysum.w);
    const int sg = cc * 16 + j;
    const int t = dir ? (L - 1 - sg) : sg;
    ys[(size_t)(row0 + t) * 512 + h * 64 + vrow] = yv;
  };
  f32x4 lda[5], ldav, ldb[5], ldbv;
  if (do_load) load_chunk(0, lda, ldav);
  __syncthreads();
  if (do_load) {
    publish_chunk(0, lda, ldav);
    load_chunk(1, lda, ldav);
    load_chunk(2, ldb, ldbv);
  }
  __syncthreads();
  auto body = [&](const int c, f32x4 (&ls)[5], f32x4& lv) {
    const int cb = c & 1;
    float* ypart = ypart0 + (solo ? cb * 4096 : 0);
    float* ypw = ypart + lane;
    if (do_comp) {
    const float* bc = buf + cb * 5120 + j * 4;
    const float* vc = vb + cb * 256 + wave * 4 + q;
    f32x4 w4n = *(const f32x4*)(bc), k4n = *(const f32x4*)(bc + 1024), ka4n = *(const f32x4*)(bc + 2048),
          kd4n = *(const f32x4*)(bc + 3072), r4n = *(const f32x4*)(bc + 4096);
    float vvn = vc[0];
#pragma unroll 2
    for (int s4 = 0; s4 < 16; s4 += 4)
#pragma unroll
    for (int ss = 0; ss < 4; ++ss) {
      const int s = s4 + ss;
      const f32x4 w4 = w4n, k4 = k4n, ka4 = ka4n, kd4 = kd4n, r4 = r4n;
      const float vv = vvn;
      if (s < 15) {
        w4n = *(const f32x4*)(bc + (s + 1) * 64);
        k4n = *(const f32x4*)(bc + 1024 + (s + 1) * 64);
        ka4n = *(const f32x4*)(bc + 2048 + (s + 1) * 64);
        kd4n = *(const f32x4*)(bc + 3072 + (s + 1) * 64);
        r4n = *(const f32x4*)(bc + 4096 + (s + 1) * 64);
        vvn = vc[(s + 1) * 16];
      }
      const f32x2 ta_ = Sa * f32x2{w4.x, w4.y} + f32x2{kd4.x, kd4.y} * vv;
      const f32x2 tb_ = Sb * f32x2{w4.z, w4.w} + f32x2{kd4.z, kd4.w} * vv;
      f32x2 pt = Sa * f32x2{k4.x, k4.y};
      pt = Sb * f32x2{k4.z, k4.w} + pt;
      float pd = pt.x + pt.y;
      pd = allred16(pd);
      const float sa = -pd;
      Sa = f32x2{ka4.x, ka4.y} * sa + ta_;
      Sb = f32x2{ka4.z, ka4.w} * sa + tb_;
      f32x2 yt = Sa * f32x2{r4.x, r4.y};
      yt = Sb * f32x2{r4.z, r4.w} + yt;
      ypw[s * 64] = yt.x + yt.y;
    }
    if (!solo) {
      asm volatile("s_waitcnt lgkmcnt(0)" ::: "memory");
      __builtin_amdgcn_wave_barrier();
      reduce_y(c, ypart);
      asm volatile("s_waitcnt lgkmcnt(0)" ::: "memory");
      __builtin_amdgcn_wave_barrier();
    }
    }
    if (do_load) {
      if (c + 1 < nch) publish_chunk(cb ^ 1, ls, lv);
      if (c + 3 < nch) load_chunk(c + 3, ls, lv);
      if (solo && c > 0) reduce_y(c - 1, ypart0 + (cb ^ 1) * 4096);
    }
    __syncthreads();
  };
  for (int c = 0; c < nch; c += 2) {
    body(c, lda, ldav);
    body(c + 1, ldb, ldbv);
  }
  if (solo && do_load) reduce_y(nch - 1, ypart0 + ((nch - 1) & 1) * 4096);
  if (isctx && do_comp) *(float4*)(p.out + OUT_RWKV + sidx) = make_float4(Sa.x, Sa.y, Sb.x, Sb.y);
}

DI void attn_item(const int tid0, const Params& p, int qrow0, const bf16_t* __restrict__ kb, const bf16_t* __restrict__ vt, int T, int kv, char* smem) {
  bf16_t* Ks = (bf16_t*)smem;
  bf16_t* Vs = Ks + 64 * 72;
  const int tid = tid0, lane = tid & 63, wave = tid >> 6, l32 = lane & 31, hh = lane >> 5;
  const int head = kv * 4 + wave;
  bf16x8 qf[4];
#pragma unroll
  for (int ks = 0; ks < 4; ++ks) qf[ks] = *(const bf16x8*)(p.qb + (size_t)(qrow0 + l32) * 512 + head * 64 + ks * 16 + hh * 8);
  f32x16 O[2];
#pragma unroll
  for (int dt = 0; dt < 2; ++dt)
#pragma unroll
    for (int e = 0; e < 16; ++e) O[dt][e] = 0.f;
  float m_run = -1e30f, lsum = 0.f;
  const int nkt = T >> 6;
  const int lr = tid >> 3, lc = (tid & 7) * 8;
  u32x4 rk[2], rv[2];
#pragma unroll
  for (int jj = 0; jj < 2; ++jj) {
    rk[jj] = *(const u32x4*)(kb + (size_t)(lr + 32 * jj) * 64 + lc);
    rv[jj] = *(const u32x4*)(vt + (size_t)(lr + 32 * jj) * T + lc);
  }
  for (int kt = 0; kt < nkt; ++kt) {
    __syncthreads();
#pragma unroll
    for (int jj = 0; jj < 2; ++jj) {
      *(u32x4*)(Ks + (lr + 32 * jj) * 72 + lc) = rk[jj];
      *(u32x4*)(Vs + (lr + 32 * jj) * 72 + lc) = rv[jj];
    }
    __syncthreads();
    if (kt + 1 < nkt) {
#pragma unroll
      for (int jj = 0; jj < 2; ++jj) {
        rk[jj] = *(const u32x4*)(kb + (size_t)((kt + 1) * 64 + lr + 32 * jj) * 64 + lc);
        rv[jj] = *(const u32x4*)(vt + (size_t)(lr + 32 * jj) * T + (kt + 1) * 64 + lc);
      }
    }
    f32x16 S[2];
#pragma unroll
    for (int m = 0; m < 2; ++m) {
#pragma unroll
      for (int e = 0; e < 16; ++e) S[m][e] = 0.f;
#pragma unroll
      for (int ks = 0; ks < 4; ++ks) {
        const bf16x8 a = *(const bf16x8*)(Ks + (32 * m + l32) * 72 + ks * 16 + hh * 8);
        S[m] = __builtin_amdgcn_mfma_f32_32x32x16_bf16(a, qf[ks], S[m], 0, 0, 0);
      }
    }
    float mx = S[0][0];
#pragma unroll
    for (int e = 1; e < 16; ++e) mx = fmaxf(mx, S[0][e]);
#pragma unroll
    for (int e = 0; e < 16; ++e) mx = fmaxf(mx, S[1][e]);
    mx = fmaxf(mx, __shfl_xor(mx, 32));
    const float mnew = fmaxf(m_run, mx);
    const float alpha = __builtin_amdgcn_exp2f(m_run - mnew);
    m_run = mnew;
    float ls = 0.f;
#pragma unroll
    for (int m = 0; m < 2; ++m)
#pragma unroll
      for (int e = 0; e < 16; ++e) {
        const float pv = __builtin_amdgcn_exp2f(S[m][e] - mnew);
        S[m][e] = pv;
        ls += pv;
      }
    lsum = lsum * alpha + ls;
#pragma unroll
    for (int dt = 0; dt < 2; ++dt)
#pragma unroll
      for (int e = 0; e < 16; ++e) O[dt][e] *= alpha;
#pragma unroll
    for (int ks2 = 0; ks2 < 4; ++ks2) {
      const int m = ks2 >> 1, u = ks2 & 1;
      uint4 pk;
      pk.x = pack2(S[m][8 * u + 0], S[m][8 * u + 1]);
      pk.y = pack2(S[m][8 * u + 2], S[m][8 * u + 3]);
      pk.z = pack2(S[m][8 * u + 4], S[m][8 * u + 5]);
      pk.w = pack2(S[m][8 * u + 6], S[m][8 * u + 7]);
      const bf16x8 pb = __builtin_bit_cast(bf16x8, pk);
#pragma unroll
      for (int dt = 0; dt < 2; ++dt) {
        const bf16x8 a = *(const bf16x8*)(Vs + (32 * dt + l32) * 72 + ks2 * 16 + hh * 8);
        O[dt] = __builtin_amdgcn_mfma_f32_32x32x16_bf16(a, pb, O[dt], 0, 0, 0);
      }
    }
  }
  lsum += __shfl_xor(lsum, 32);
  const float inv = 1.f / lsum;
  bf16_t* orow = p.hb + (size_t)(qrow0 + l32) * 1024 + head * 64;
#pragma unroll
  for (int dt = 0; dt < 2; ++dt)
#pragma unroll
    for (int i4 = 0; i4 < 4; ++i4) {
      const int d = 32 * dt + 8 * i4 + 4 * hh;
      *(uint2*)(orow + d) = make_uint2(pack2(O[dt][4 * i4] * inv, O[dt][4 * i4 + 1] * inv), pack2(O[dt][4 * i4 + 2] * inv, O[dt][4 * i4 + 3] * inv));
    }
}

DI void scanattn_phase(const int tidfull, const int ci, const Params& p, char* smem_full) {
  __shared__ int s_item;
  const int i = ci & 7;
  const int half = tidfull >> 8, tid0 = tidfull & 255;
  char* smem = smem_full + half * HALF_LDS;
  constexpr int TOTAL = 1024;
  while (true) {
    __syncthreads();
    if (tidfull == 0) s_item = (int)atomicAdd(p.cnt + ci, 1u);
    __syncthreads();
    const int pid = s_item;
    if (pid >= TOTAL + (i == 0 ? N_CONV_LATE_A / 2 : N_CONV_LATE_B / 2)) break;
    if (pid >= TOTAL) {
      const int qq = (pid - TOTAL) * 2 + half;
      conv_by_T(tid0, p, i == 0 ? conv_lateA_T(qq) : conv_lateB_T(qq), (float*)smem);
      continue;
    }
    if (pid < 128) {
      const int id = pid;
      wkv_item(tid0, p, i, false, id >> 6, (id >> 3) & 7, (id >> 2) & 1, id & 3, smem_full, half == 0, half == 1);
    } else if (pid < 384) {
      const int a = (pid - 128) * 2 + half, b = a >> 8, kv = (a >> 7) & 1, qt = a & 127;
      attn_item(tid0, p, 4096 + b * 4096 + qt * 32, p.kbl + (size_t)(b * 2 + kv) * 4352 * 64, p.vtl + (size_t)(b * 2 + kv) * 64 * 4352, 4352, kv, smem);
    } else if (pid < 896) {
      const int a = (pid - 384) * 2 + half;
      wkv_item(tid0, p, i, true, a >> 6, (a >> 3) & 7, (a >> 2) & 1, a & 3, smem, true, true);
    } else {
      const int a = (pid - 896) * 2 + half, b = a >> 4, kv = (a >> 3) & 1, qt = a & 7;
      attn_item(tid0, p, b * 256 + qt * 32, p.kbc + (size_t)(b * 2 + kv) * 256 * 64, p.vtc + (size_t)(b * 2 + kv) * 64 * 256, 256, kv, smem);
    }
  }
}

DI void fin_phase(const int tid0, const int vb, const int vg, const Params& p, int i) {
  const int lane = tid0 & 63, wave = tid0 >> 6;
  const float* KDf = p.pw + (size_t)2 * SZ512;
  const float* KDb = p.pw + (size_t)5 * SZ512;
  float rk[8], lw[8], lb[8];
#pragma unroll
  for (int h = 0; h < 8; ++h) {
    const int c = i * 512 + h * 64 + lane;
    rk[h] = p.r_k[c]; lw[h] = p.ln_w[c]; lb[h] = p.ln_b[c];
  }
  for (int rb = vb; rb < NTOK / 4; rb += vg) {
    const int row = rb * 4 + wave;
    const size_t o0 = (size_t)row * 512 + lane;
    float r[8], vv[8], kd[8], ya[8], yb[8], gt[8];
#pragma unroll
    for (int h = 0; h < 8; ++h) {
      const size_t o = o0 + h * 64;
      r[h] = p.r[o]; vv[h] = p.v[o]; kd[h] = KDf[o] + KDb[o]; ya[h] = p.y[o]; yb[h] = p.y[SZ512 + o]; gt[h] = p.gt[o];
    }
    float ov[8];
#pragma unroll
    for (int h = 0; h < 8; ++h) {
      const float bsum = wave_sum(r[h] * rk[h] * kd[h]);
      const float yv = ya[h] + yb[h] + bsum * vv[h];
      const float mean = wave_sum(yv) * (1.f / 64.f);
      const float dl = yv - mean;
      const float var = wave_sum(dl * dl) * (1.f / 64.f);
      const float yn = dl * rsqrtf(var + 64e-5f);
      ov[h] = (yn * lw[h] + lb[h]) * gt[h];
    }
#pragma unroll
    for (int h = 0; h < 8; ++h) p.hb[(size_t)row * 1024 + 512 + h * 64 + lane] = f2bf(ov[h]);
  }
}

DI void s5_phase(const int tid0, const int vb, const int vg, const Params& p, int i, char* smem) {
  const int tid = tid0, lane = tid & 63, wave = tid >> 6, l32 = lane & 31, hh = lane >> 5, l16 = lane & 15, q16 = lane >> 4;
  bf16_t* Hs = (bf16_t*)smem + wave * (2 * 16 * 136);
  constexpr int NUNIT = 1152;
  for (int slot = vb; slot < NUNIT / 4; slot += vg) {
    const int ub = slot < 64 ? ((slot & 1) ? 32 + (slot >> 1) : (slot >> 1)) : slot;
    const int unit = ub * 4 + wave;
    bool isctx; int pair, g, dir;
    if (unit < 128) { isctx = false; pair = 0; g = unit >> 1; dir = unit & 1; }
    else { const int a = unit - 128; isctx = true; pair = a >> 7; g = (a >> 1) & 63; dir = a & 1; }
    const int L = isctx ? 256 : 4096;
    const int bme = pair * 2 + hh;
    const int id = i * 2 + dir;
    const int a_bsel = (l32 >> 2) & 1, a_tok = 4 * (l32 >> 3) + (l32 & 3);
    const int a_b = pair * 2 + a_bsel;
    const size_t a_row0 = isctx ? (size_t)a_b * 256 : 4096 + (size_t)a_b * 4096;
    const float* ua = p.u + a_row0 * 1024 + g * 16 + hh * 8;
    bf16x8 bbf[4];
#pragma unroll
    for (int nt = 0; nt < 4; ++nt) bbf[nt] = *(const bf16x8*)(p.s5bbt + (size_t)(id * 64 + g) * 2048 + (nt * 32 + l32) * 16 + hh * 8);
    bf16x8 cmf[4];
#pragma unroll
    for (int ks = 0; ks < 4; ++ks) cmf[ks] = *(const bf16x8*)(p.s5cmt + (size_t)(id * 64 + g) * 2048 + l16 * 128 + ks * 32 + q16 * 8);
    const float2 ab0 = *(const float2*)(p.s5ab + ((size_t)id * 4096 + g * 64 + l32) * 2);
    const float2 ab1 = *(const float2*)(p.s5ab + ((size_t)id * 4096 + g * 64 + 32 + l32) * 2);
    float hr0 = 0.f, hi0 = 0.f, hr1 = 0.f, hi1 = 0.f;
    const size_t sbase = ((((size_t)bme * 2 + i) * 2 + dir) * 2) * 4096 + g * 64 + l32;
    if (!isctx) {
      hr0 = p.state_s5[sbase]; hi0 = p.state_s5[sbase + 4096];
      hr1 = p.state_s5[sbase + 32]; hi1 = p.state_s5[sbase + 4096 + 32];
    }
    float* yout = p.ysd + (size_t)dir * NTOK * 1024;
    const int nch = L >> 4;
    f32x4 pa0, pa1, pb0, pb1, pc0 = {0.f, 0.f, 0.f, 0.f}, pc1 = {0.f, 0.f, 0.f, 0.f};
    {
      const int t00 = dir ? (L - 16) : 0;
      pa0 = *(const f32x4*)(ua + (size_t)(t00 + a_tok) * 1024);
      pa1 = *(const f32x4*)(ua + (size_t)(t00 + a_tok) * 1024 + 4);
      const int t01 = dir ? (L - 32) : 16;
      pb0 = *(const f32x4*)(ua + (size_t)(t01 + a_tok) * 1024);
      pb1 = *(const f32x4*)(ua + (size_t)(t01 + a_tok) * 1024 + 4);
    }
    for (int c = 0; c < nch; ++c) {
      const int t0 = dir ? (L - 16 * (c + 1)) : 16 * c;
      if (c + 2 < nch) {
        const int t2 = dir ? (L - 16 * (c + 3)) : 16 * (c + 2);
        pc0 = *(const f32x4*)(ua + (size_t)(t2 + a_tok) * 1024);
        pc1 = *(const f32x4*)(ua + (size_t)(t2 + a_tok) * 1024 + 4);
      }
      const f32x4 u0 = pa0, u1 = pa1;
      pa0 = pb0; pa1 = pb1; pb0 = pc0; pb1 = pc1;
      uint4 up;
      up.x = pack2(u0.x, u0.y); up.y = pack2(u0.z, u0.w); up.z = pack2(u1.x, u1.y); up.w = pack2(u1.z, u1.w);
      const bf16x8 af = __builtin_bit_cast(bf16x8, up);
      f32x16 bu[4];
#pragma unroll
      for (int nt = 0; nt < 4; ++nt) {
#pragma unroll
        for (int e = 0; e < 16; ++e) bu[nt][e] = 0.f;
        bu[nt] = __builtin_amdgcn_mfma_f32_32x32x16_bf16(af, bbf[nt], bu[nt], 0, 0, 0);
      }
      unsigned* hrow = (unsigned*)(Hs + hh * (16 * 136)) + l32;
      if (dir == 0) {
#pragma unroll
        for (int e = 0; e < 16; ++e) {
          const float nr0 = ab0.x * hr0 - ab0.y * hi0 + bu[0][e];
          const float ni0 = ab0.x * hi0 + ab0.y * hr0 + bu[2][e];
          const float nr1 = ab1.x * hr1 - ab1.y * hi1 + bu[1][e];
          const float ni1 = ab1.x * hi1 + ab1.y * hr1 + bu[3][e];
          hr0 = nr0; hi0 = ni0; hr1 = nr1; hi1 = ni1;
          hrow[e * 68] = pack2(hr0, hi0); hrow[e * 68 + 32] = pack2(hr1, hi1);
        }
      } else {
#pragma unroll
        for (int e = 15; e >= 0; --e) {
          const float nr0 = ab0.x * hr0 - ab0.y * hi0 + bu[0][e];
          const float ni0 = ab0.x * hi0 + ab0.y * hr0 + bu[2][e];
          const float nr1 = ab1.x * hr1 - ab1.y * hi1 + bu[1][e];
          const float ni1 = ab1.x * hi1 + ab1.y * hr1 + bu[3][e];
          hr0 = nr0; hi0 = ni0; hr1 = nr1; hi1 = ni1;
          hrow[e * 68] = pack2(hr0, hi0); hrow[e * 68 + 32] = pack2(hr1, hi1);
        }
      }
      __builtin_amdgcn_fence(__ATOMIC_RELEASE, "wavefront");
      asm volatile("s_waitcnt lgkmcnt(0)" ::: "memory");
      __builtin_amdgcn_wave_barrier();
      f32x4 yt[2];
#pragma unroll
      for (int mt = 0; mt < 2; ++mt) {
        yt[mt][0] = 0.f; yt[mt][1] = 0.f; yt[mt][2] = 0.f; yt[mt][3] = 0.f;
#pragma unroll
        for (int ks = 0; ks < 4; ++ks) {
          const bf16x8 a = *(const bf16x8*)(Hs + mt * (16 * 136) + l16 * 136 + ks * 32 + q16 * 8);
          yt[mt] = __builtin_amdgcn_mfma_f32_16x16x32_bf16(a, cmf[ks], yt[mt], 0, 0, 0);
        }
      }
      asm volatile("s_waitcnt lgkmcnt(0)" ::: "memory");
      __builtin_amdgcn_wave_barrier();
#pragma unroll
      for (int mt = 0; mt < 2; ++mt) {
        const int bb_ = pair * 2 + mt;
        const size_t r0 = isctx ? (size_t)bb_ * 256 : 4096 + (size_t)bb_ * 4096;
#pragma unroll
        for (int rr = 0; rr < 4; ++rr) yout[(r0 + t0 + 4 * q16 + rr) * 1024 + g * 16 + l16] = yt[mt][rr];
      }
    }
    if (isctx) {
      float* so = p.out + OUT_S5 + sbase;
      so[0] = hr0; so[4096] = hi0; so[32] = hr1; so[4096 + 32] = hi1;
    }
  }
}

DI void s5post_phase(const int tid0, const int vb, const int vg, const Params& p, int i) {
  const size_t total4 = (size_t)NTOK * 1024 / 4;
  const float* y0 = p.ysd;
  const float* y1 = p.ysd + (size_t)NTOK * 1024;
  for (size_t idx = (size_t)vb * 256 + tid0; idx < total4; idx += (size_t)vg * 256) {
    const float4 a = *(const float4*)(y0 + idx * 4);
    const float4 b = *(const float4*)(y1 + idx * 4);
    const float4 uu = *(const float4*)(p.u + idx * 4);
    const int col = (int)((idx * 4) & 1023);
    const float4 dd = *(const float4*)(p.s5_d + i * 1024 + col);
    float z[4] = {a.x + b.x + dd.x * uu.x, a.y + b.y + dd.y * uu.y, a.z + b.z + dd.z * uu.z, a.w + b.w + dd.w * uu.w};
#pragma unroll
    for (int e = 0; e < 4; ++e) {
      const float x = z[e];
      const float inner = 0.7978845608028654f * (x + 0.044715f * x * x * x);
      const float th = 1.f - 2.f / (1.f + __expf(2.f * inner));
      z[e] = 0.5f * x * (1.f + th);
    }
    *(uint2*)(p.zb + idx * 4) = make_uint2(pack2(z[0], z[1]), pack2(z[2], z[3]));
  }
}

#define XB_TMO      128
#define XB_XCNT(j)  (256  + 64 * (j))
#define XB_XSUB(j)  (1280 + 64 * (j))
#define XB_XGEN(j)  (2304 + 64 * (j))
#define XB_TOP      3328
#define XB_TOPGEN   3392
#define XCD_BAR_WORDS 3456
#define XB_SPIN_CAP (1u << 18)
#define LAS __attribute__((address_space(3)))

__device__ __forceinline__ unsigned xb_ld(unsigned* p)              { return __hip_atomic_load(p, __ATOMIC_RELAXED, __HIP_MEMORY_SCOPE_AGENT); }
__device__ __forceinline__ unsigned xb_add(unsigned* p, unsigned v) { return __hip_atomic_fetch_add(p, v, __ATOMIC_RELAXED, __HIP_MEMORY_SCOPE_AGENT); }
__device__ __forceinline__ unsigned xb_xcc_id() { return (unsigned)__builtin_amdgcn_s_getreg((3 << 11) | 20) & 0xFu; }
#define XB_SPIN(cond, bar) do { unsigned _sp = 0; while (cond) { __builtin_amdgcn_s_sleep(1); \
    if ((++_sp & 255u) == 0u) { if (xb_ld(&(bar)[XB_TMO])) break; if (_sp > XB_SPIN_CAP) { atomicAdd(&(bar)[XB_TMO], 1u); break; } } } } while (0)

struct XcdBarrier {
    unsigned* bar; unsigned x;
    volatile LAS unsigned* st;
};

__device__ __forceinline__ XcdBarrier xcd_barrier_post(unsigned* bar, volatile LAS unsigned* st) {
    XcdBarrier b; b.bar = bar; b.x = xb_xcc_id(); b.st = st;
    if (threadIdx.x == 0) (void)xb_add(&bar[XB_XCNT(b.x)], 1u);
    return b;
}
__device__ __forceinline__ void xcd_barrier_complete(unsigned* bar, unsigned x, unsigned& nloc, unsigned& nx) {
    const unsigned G = gridDim.x * gridDim.y * gridDim.z;
    unsigned sum, cnt, mine, sp = 0u;
    for (;;) {
        sum = 0u; cnt = 0u; mine = 0u;
#pragma unroll
        for (unsigned j = 0; j < 16; ++j) { const unsigned c = xb_ld(&bar[XB_XCNT(j)]); sum += c; cnt += (c > 0u) ? 1u : 0u; mine = (j == x) ? c : mine; }
        if (sum == G) break;
        __builtin_amdgcn_s_sleep(1);
        if ((++sp & 255u) == 0u) { if (xb_ld(&bar[XB_TMO])) break; if (sp > XB_SPIN_CAP) { atomicAdd(&bar[XB_TMO], 1u); break; } }
    }
    nloc = mine > 0u ? mine : 1u; nx = cnt > 0u ? cnt : 1u;
}

__device__ __forceinline__ void xcd_barrier(const XcdBarrier& b) {
    asm volatile("s_waitcnt vmcnt(0)" ::: "memory");
    __syncthreads();
    if (threadIdx.x == 0) {
        unsigned* bar = b.bar;
        __builtin_amdgcn_s_waitcnt(0);
        unsigned nloc = b.st[0], nx = b.st[1];
        if (nloc == 0u) { xcd_barrier_complete(bar, b.x, nloc, nx); b.st[0] = nloc; b.st[1] = nx; }
        const unsigned old = xb_add(&bar[XB_XSUB(b.x)], 1u);
        const unsigned gen = old / nloc;
        if (old + 1u == (gen + 1u) * nloc) {
            __builtin_amdgcn_fence(__ATOMIC_RELEASE, "agent");
            asm volatile("s_waitcnt vmcnt(0)" ::: "memory");
            const unsigned og = xb_add(&bar[XB_TOP], 1u);
            const unsigned tg = og / nx;
            if (og + 1u == (tg + 1u) * nx) xb_add(&bar[XB_TOPGEN], 1u);
            else XB_SPIN(xb_ld(&bar[XB_TOPGEN]) == tg, bar);
            __builtin_amdgcn_fence(__ATOMIC_ACQUIRE, "agent");
            xb_add(&bar[XB_XGEN(b.x)], 1u);
            asm volatile("s_waitcnt vmcnt(0)" ::: "memory");
        } else {
            XB_SPIN(xb_ld(&bar[XB_XGEN(b.x)]) == gen, bar);
            __builtin_amdgcn_fence(__ATOMIC_ACQUIRE, "agent");
            asm volatile("s_waitcnt vmcnt(0)" ::: "memory");
        }
    }
    __syncthreads();
}


DI void grid_barrier(unsigned* bar, unsigned target) {
  asm volatile("s_waitcnt vmcnt(0)" ::: "memory");
  __syncthreads();
  if (threadIdx.x == 0) {
    __builtin_amdgcn_fence(__ATOMIC_RELEASE, "agent");
    asm volatile("s_waitcnt vmcnt(0)" ::: "memory");
    __hip_atomic_fetch_add(bar, 1u, __ATOMIC_RELAXED, __HIP_MEMORY_SCOPE_AGENT);
    while (__hip_atomic_load(bar, __ATOMIC_RELAXED, __HIP_MEMORY_SCOPE_AGENT) < target) __builtin_amdgcn_s_sleep(1);
    __builtin_amdgcn_fence(__ATOMIC_ACQUIRE, "agent");
    asm volatile("s_waitcnt vmcnt(0)" ::: "memory");
  }
  __syncthreads();
}

__global__ void __launch_bounds__(512) mega(Params p, int pb, int pe) {
  extern __shared__ __attribute__((aligned(16))) char smem[];
  cg::grid_group grid = cg::this_grid();
  unsigned nbar = 0;
  __shared__ uint4 xb_words;
  if (threadIdx.x == 0) xb_words = make_uint4(0u, 0u, 0u, 0u);
  __syncthreads();
  XcdBarrier xb = xcd_barrier_post(p.xbar, (volatile LAS unsigned*)&xb_words);
  for (int ph = pb; ph < pe; ++ph) {
    int op = 0, l = 0, gk = 0, gj = 0, rsub = 0;
    bool hprev = true, hnext = true;
    if (ph == 0) op = 0;
    else if (ph == NPHASE - 1) { op = 1; l = 4; rsub = 0; hnext = false; }
    else {
      const int q = ph - 1, lp = q / 25, r = q % 25;
      const bool even = r < 13;
      l = even ? 2 * lp : 2 * lp + 1;
      const int st = even ? r : r - 13;
      const int nmix = even ? 6 : 5;
      if (st == 0) { op = 1; rsub = 0; hprev = l > 0; }
      else if (st == 1) { op = 2; gk = G_UP; gj = 0; }
      else if (st == 2) { op = 2; gk = G_DOWN; gj = 0; }
      else if (st == 3) { op = 1; rsub = 1; }
      else if (st == 4 + nmix) { op = 1; rsub = 2; }
      else if (st == 5 + nmix) { op = 2; gk = G_UP; gj = 1; }
      else if (st == 6 + nmix) { op = 2; gk = G_DOWN; gj = 1; }
      else if (even) {
        if (st == 4) { op = 2; gk = G_ABIN; }
        else if (st == 5) op = 3;
        else if (st == 6) { op = 2; gk = G_LORA; }
        else if (st == 7) op = 4;
        else if (st == 8) op = 5;
        else { op = 2; gk = G_ABOUT; }
      } else {
        if (st == 4) { op = 2; gk = G_S5IN; }
        else if (st == 5) op = 6;
        else if (st == 6) op = 7;
        else if (st == 7) { op = 2; gk = G_GLU; }
        else { op = 2; gk = G_S5OUT; }
      }
    }
    const int i = l >> 1;
#ifdef DUPMASK
    const int nrep = ((DUPMASK >> op) & 1) ? 2 : 1;
#else
    const int nrep = 1;
#endif
    for (int rep = 0; rep < nrep; ++rep) {
    if (rep) grid.sync();
    int tidf = (int)__builtin_amdgcn_workitem_id_x();
    asm volatile("" : "+v"(tidf));
    const int half = tidf >> 8, tidr = tidf & 255;
    const int vb = blockIdx.x * 2 + half, vg = gridDim.x * 2;
    char* hsm = smem + half * HALF_LDS;
    switch (op) {
      case 0: init_phase(tidr, vb, vg, p, hsm); break;
      case 1: row_phase(tidr, vb, vg, p, l, rsub, hprev, hnext); break;
      case 2: gemm_phase(tidf, p, gk, l, gj, smem); break;
      case 3: prep_phase(tidr, vb, vg, p, i); break;
      case 4: scanattn_phase(tidf, i + 8 * rep, p, smem); break;
      case 5: fin_phase(tidr, vb, vg, p, i); break;
      case 6: s5_phase(tidr, vb, vg, p, i, hsm); break;
      default: s5post_phase(tidr, vb, vg, p, i); break;
    }
    }
    if (pe - pb > 1 && ph + 1 < pe) {
      if (pe > NPHASE) grid.sync();
      xcd_barrier(xb);
    }
  }
}

extern "C" void kernel_launch(void* const* d_in, const int* in_sizes, int n_in, void* d_out, int out_size, void* d_ws, size_t ws_size, hipStream_t stream) {
  Params p{};
  const float** pf = (const float**)&p;
  for (int k = 0; k < 41; ++k) pf[k] = (const float*)d_in[k];
  p.out = (float*)d_out;
  char* ws = (char*)d_ws;
  size_t off = 0;
  auto alloc = [&](size_t bytes) { char* r = ws + off; off += (bytes + 255) & ~(size_t)255; return r; };
  p.w13t = (bf16_t*)alloc((size_t)8 * 5632 * 1024 * 2);
  p.w2t = (bf16_t*)alloc((size_t)8 * 1024 * 2816 * 2);
  p.abint = (bf16_t*)alloc((size_t)2 * 2816 * 1024 * 2);
  p.aboutt = (bf16_t*)alloc((size_t)2 * 1048576 * 2);
  p.s5int = (bf16_t*)alloc((size_t)2 * 1048576 * 2);
  p.s5glut = (bf16_t*)alloc((size_t)2 * 1048576 * 2);
  p.s5outt = (bf16_t*)alloc((size_t)2 * 1048576 * 2);
  p.wupt = (bf16_t*)alloc((size_t)4 * 32768 * 2);
  p.aupt = (bf16_t*)alloc((size_t)4 * 32768 * 2);
  p.gupt = (bf16_t*)alloc((size_t)2 * 65536 * 2);
  p.mod = (float*)alloc((size_t)3 * 4 * 9216 * 4);
  p.rope = (float*)alloc(8192);
  p.s5ab = (float*)alloc((size_t)16384 * 2 * 4);
  p.s5bbt = (bf16_t*)alloc((size_t)4 * 64 * 2048 * 2);
  p.s5cmt = (bf16_t*)alloc((size_t)4 * 64 * 2048 * 2);
  p.cnt = (unsigned*)alloc(256);
  p.xbar = (unsigned*)alloc((size_t)XCD_BAR_WORDS * 4);
  p.hb = (bf16_t*)alloc((size_t)NTOK * 1024 * 2);
  p.y = (float*)alloc((size_t)NTOK * 1024 * 4);
  const size_t offB = off;
  p.g = (bf16_t*)alloc((size_t)NTOK * 2816 * 2);
  off = offB;
  p.pw = (float*)alloc((size_t)6 * SZ512 * 4);
  p.qb = (bf16_t*)alloc((size_t)NTOK * 512 * 2);
  p.kbc = (bf16_t*)alloc((size_t)16 * 2 * 256 * 64 * 2);
  p.kbl = (bf16_t*)alloc((size_t)2 * 2 * 4352 * 64 * 2);
  p.vtc = (bf16_t*)alloc((size_t)16 * 2 * 256 * 64 * 2);
  p.vtl = (bf16_t*)alloc((size_t)2 * 2 * 4352 * 64 * 2);
  p.r = (float*)alloc(SZ512 * 4);
  p.kk = (float*)alloc(SZ512 * 4);
  p.v = (float*)alloc(SZ512 * 4);
  p.kraw = (float*)alloc(SZ512 * 4);
  p.la = (bf16_t*)alloc((size_t)NTOK * 384 * 2);
  p.gt = (float*)alloc(SZ512 * 4);
  const size_t endEven = off;
  off = offB;
  p.u = (float*)alloc((size_t)NTOK * 1024 * 4);
  p.ysd = (float*)alloc((size_t)2 * NTOK * 1024 * 4);
  p.zb = (bf16_t*)alloc((size_t)NTOK * 1024 * 2);
  p.z2b = (bf16_t*)alloc((size_t)NTOK * 1024 * 2);
  const size_t endOdd = off;
  const size_t need = endEven > endOdd ? endEven : endOdd;
  if (need > ws_size) { fprintf(stderr, "workspace too small: need %zu have %zu\n", need, ws_size); return; }

#if COOP
  static int grid_blocks = 0;
  if (!grid_blocks) {
    int dev = 0, cus = 0, per_cu = 0;
    hipGetDevice(&dev);
    hipDeviceGetAttribute(&cus, hipDeviceAttributeMultiprocessorCount, dev);
    hipFuncSetAttribute((const void*)mega, hipFuncAttributeMaxDynamicSharedMemorySize, SMEM_BYTES);
    hipOccupancyMaxActiveBlocksPerMultiprocessor(&per_cu, mega, 512, SMEM_BYTES);
    if (per_cu > 1) per_cu = 1;
    if (per_cu < 1) per_cu = 1;
    grid_blocks = cus * per_cu;
  }
  hipMemsetAsync(p.xbar, 0, (size_t)XCD_BAR_WORDS * 4, stream);
  int pb = 0, pe = NPHASE;
  void* args[] = {&p, &pb, &pe};
  hipError_t e = hipLaunchCooperativeKernel((void*)mega, dim3(grid_blocks), dim3(512), args, SMEM_BYTES, stream);
  if (e != hipSuccess) fprintf(stderr, "cooperative launch failed: %s (grid %d)\n", hipGetErrorString(e), grid_blocks);
#else
  for (int ph = 0; ph < NPHASE; ++ph) mega<<<256, 512, SMEM_BYTES, stream>>>(p, ph, ph + 1);
#endif
}
```

```cpp
#include <hip/hip_runtime.h>
#include <hip/hip_cooperative_groups.h>
#include <stdint.h>
#include <cstdio>
namespace cg = cooperative_groups;

#ifndef COOP
#define COOP 1
#endif

typedef unsigned short bf16_t;
typedef short bf16x8 __attribute__((ext_vector_type(8)));
typedef float f32x16 __attribute__((ext_vector_type(16)));
typedef float f32x4 __attribute__((ext_vector_type(4)));
typedef float f32x2 __attribute__((ext_vector_type(2)));
typedef unsigned u32x4 __attribute__((ext_vector_type(4)));
typedef unsigned u32x2 __attribute__((ext_vector_type(2)));
typedef __bf16 bf2_t __attribute__((ext_vector_type(2)));
#define DI __device__ __forceinline__

constexpr int NTOK = 12288;
constexpr size_t SZ512 = (size_t)NTOK * 512;
constexpr int NPHASE = 52;
constexpr int HALF_LDS = 60416;
constexpr int SMEM_BYTES = 2 * HALF_LDS;
constexpr float RMS_EPS = 1e-6f;
constexpr float QSCALE = 0.125f * 1.4426950408889634f;

constexpr size_t OUT_NEWK = 12582912, OUT_NEWV = 13631488, OUT_RWKV = 14680064, OUT_S5 = 16777216;

struct Params {
  const float *x_prompt, *x_sample, *cache_k, *cache_v, *state_rwkv, *state_s5, *c, *c_ctx, *ada_w, *ada_b, *norm_pre, *norm_post,
      *ffn_w1, *ffn_w3, *ffn_w2, *ab_w_in, *ab_w_out, *q_gain, *k_gain, *mu, *w0, *w_up, *a0, *a_up, *g_up, *k_k, *k_a, *r_k, *ln_w, *ln_b,
      *s5_w_in, *lam_re, *lam_im, *log_dt, *b_re, *b_im, *c_re, *c_im, *s5_d, *s5_w_glu, *s5_w_out;
  float* out;
  bf16_t *w13t, *w2t, *abint, *aboutt, *s5int, *s5glut, *s5outt, *wupt, *aupt, *gupt;
  float *mod, *rope, *s5ab;
  bf16_t *s5bbt, *s5cmt;
  unsigned* cnt;
  unsigned* xbar;
  bf16_t* hb;
  float* y;
  bf16_t* g;
  float* pw;
  bf16_t *qb, *kbc, *kbl, *vtc, *vtl;
  float *r, *kk, *v, *kraw;
  bf16_t* la;
  float* gt;
  float *u, *ysd;
  bf16_t *zb, *z2b;
};

DI unsigned pack2(float lo, float hi) {
  f32x2 v; v.x = lo; v.y = hi;
  bf2_t b = __builtin_convertvector(v, bf2_t);
  return __builtin_bit_cast(unsigned, b);
}
DI bf16_t f2bf(float x) { return (bf16_t)(pack2(x, 0.f) & 0xffffu); }
DI float bf2f(bf16_t h) { return __uint_as_float(((unsigned)h) << 16); }
DI float sigmoidf_(float x) { return 1.f / (1.f + __expf(-x)); }
DI float allred16(float x);
DI float wave_sum(float v) {
  v = allred16(v);
  v += __shfl_xor(v, 16);
  v += __shfl_xor(v, 32);
  return v;
}
DI float allred16(float x) {
  x += __int_as_float(__builtin_amdgcn_update_dpp(0, __float_as_int(x), 0xB1, 0xF, 0xF, true));
  x += __int_as_float(__builtin_amdgcn_update_dpp(0, __float_as_int(x), 0x4E, 0xF, 0xF, true));
  x += __int_as_float(__builtin_amdgcn_update_dpp(0, __float_as_int(x), 0x141, 0xF, 0xF, true));
  x += __int_as_float(__builtin_amdgcn_update_dpp(0, __float_as_int(x), 0x140, 0xF, 0xF, true));
  return x;
}
DI int vperm(int t) { const int k = t & 15; return (t & ~15) | (8 * ((k >> 2) & 1) + 4 * (k >> 3) + (k & 3)); }

DI void dsincos(double x, double& s, double& c) {
  const double k = rint(x * 0.15915494309189533576888);
  double r = fma(-k, 6.28318530717958623200e+00, x);
  r = fma(-k, 2.44929359829470635445e-16, r);
  const double r2 = r * r;
  double ts = r, tc = 1.0;
  s = r; c = 1.0;
#pragma unroll
  for (int n = 1; n <= 16; ++n) {
    tc *= -r2 * (1.0 / (double)((2 * n - 1) * (2 * n)));
    ts *= -r2 * (1.0 / (double)((2 * n) * (2 * n + 1)));
    c += tc; s += ts;
  }
}

DI void conv_tile(const int tid0, const float* __restrict__ src, bf16_t* __restrict__ dst, int K, int N, int kt, int nt, int mode, float* sm) {
  const int tid = tid0;
  const int k0 = kt * 64, n0 = nt * 64;
#pragma unroll
  for (int j = 0; j < 4; ++j) {
    const int row = (tid >> 4) + 16 * j;
    const float4 v = *(const float4*)(src + (size_t)(k0 + row) * N + n0 + (tid & 15) * 4);
    float* d = sm + row * 65 + (tid & 15) * 4;
    d[0] = v.x; d[1] = v.y; d[2] = v.z; d[3] = v.w;
  }
  __syncthreads();
  const int n = tid >> 2, kq = tid & 3;
  unsigned w[8];
#pragma unroll
  for (int j = 0; j < 8; ++j) w[j] = pack2(sm[(kq * 16 + 2 * j) * 65 + n], sm[(kq * 16 + 2 * j + 1) * 65 + n]);
  const int ng = n0 + n;
  int drow = ng;
  if (mode == 1) drow = 64 * (ng >> 5) + (ng & 31);
  else if (mode == 2) drow = 64 * (ng >> 5) + 32 + (ng & 31);
  uint4* dp = (uint4*)(dst + (size_t)drow * K + k0 + kq * 16);
  dp[0] = make_uint4(w[0], w[1], w[2], w[3]);
  dp[1] = make_uint4(w[4], w[5], w[6], w[7]);
  __syncthreads();
}

DI void conv_by_T(const int tid0, const Params& p, int T, float* sm) {
      const float* src; bf16_t* dst; int K, N, kt, nt, mode = 0;
      if (T < 5632) { const int m = T / 704, r = T % 704; kt = r / 44; nt = r % 44; K = 1024; N = 2816; src = p.ffn_w1 + (size_t)m * 1024 * 2816; dst = p.w13t + (size_t)m * 5632 * 1024; mode = 1; }
      else if (T < 11264) { T -= 5632; const int m = T / 704, r = T % 704; kt = r / 44; nt = r % 44; K = 1024; N = 2816; src = p.ffn_w3 + (size_t)m * 1024 * 2816; dst = p.w13t + (size_t)m * 5632 * 1024; mode = 2; }
      else if (T < 16896) { T -= 11264; const int m = T / 704, r = T % 704; kt = r / 16; nt = r % 16; K = 2816; N = 1024; src = p.ffn_w2 + (size_t)m * 2816 * 1024; dst = p.w2t + (size_t)m * 1024 * 2816; }
      else if (T < 18240) { T -= 16896; const int m = T / 672, r = T % 672; kt = r / 42; nt = r % 42; K = 1024; N = 2688; src = p.ab_w_in + (size_t)m * 1024 * 2688; dst = p.abint + (size_t)m * 2816 * 1024; }
      else if (T < 20288) {
        T -= 18240; const int grp = T / 512; T %= 512;
        const int m = T / 256, r = T % 256; kt = r / 16; nt = r % 16; K = 1024; N = 1024;
        const float* s0 = grp == 0 ? p.ab_w_out : grp == 1 ? p.s5_w_in : grp == 2 ? p.s5_w_glu : p.s5_w_out;
        bf16_t* d0 = grp == 0 ? p.aboutt : grp == 1 ? p.s5int : grp == 2 ? p.s5glut : p.s5outt;
        src = s0 + (size_t)m * 1048576; dst = d0 + (size_t)m * 1048576;
      }
      else if (T < 20320) { T -= 20288; const int m = T / 8; kt = 0; nt = T % 8; K = 64; N = 512; src = p.w_up + (size_t)m * 32768; dst = p.wupt + (size_t)m * 32768; }
      else if (T < 20352) { T -= 20320; const int m = T / 8; kt = 0; nt = T % 8; K = 64; N = 512; src = p.a_up + (size_t)m * 32768; dst = p.aupt + (size_t)m * 32768; }
      else { T -= 20352; const int m = T / 16, r = T % 16; kt = r / 8; nt = r % 8; K = 128; N = 512; src = p.g_up + (size_t)m * 65536; dst = p.gupt + (size_t)m * 65536; }
      conv_tile(tid0, src, dst, K, N, kt, nt, mode, sm);
}

constexpr int N_CONV_EARLY = 2832;
DI int conv_early_T(int e) {
  if (e < 704) return e;
  if (e < 1408) return 5632 + (e - 704);
  if (e < 2112) return 11264 + (e - 1408);
  if (e < 2784) return 16896 + (e - 2112);
  if (e < 2800) return 20288 + (e - 2784);
  if (e < 2816) return 20320 + (e - 2800);
  return 20352 + (e - 2816);
}
constexpr int N_CONV_LATE_A = 10192, N_CONV_LATE_B = 7360;
DI int conv_lateA_T(int q) {
  if (q < 8448) return (q / 2816) * 5632 + 704 + (q % 2816);
  if (q < 9120) return 16896 + 672 + (q - 8448);
  if (q < 10144) { const int r = q - 9120; return 18240 + (r >> 8) * 512 + (r & 255); }
  const int r = q - 10144;
  if (r < 16) return 20288 + 16 + r;
  if (r < 32) return 20320 + 16 + (r - 16);
  return 20352 + 16 + (r - 32);
}
DI int conv_lateB_T(int q) {
  if (q < 6336) return (q / 2112) * 5632 + 3520 + (q % 2112);
  const int r = q - 6336;
  return 18240 + (r >> 8) * 512 + 256 + (r & 255);
}

DI void init_phase(const int tid0, const int vb, const int vg, const Params& p, char* smem) {
  float* sm = (float*)smem;
  const int tid = tid0;
  constexpr int N_MOD = 576, N_S5 = 64, N_MISC = 2, N_CONV = N_CONV_EARLY;
  constexpr int TOTAL = N_MOD + N_S5 + N_MISC + N_CONV;
  for (int it = vb; it < TOTAL; it += vg) {
    if (it < N_MOD) {
      const int l = it / 144, eb = it % 144, e0 = eb * 64;
      for (int idx = tid; idx < 3072; idx += 256) {
        const int set = idx >> 10, d = idx & 1023;
        const float cv = (set == 0) ? p.c_ctx[d] : p.c[(set - 1) * 1024 + d];
        sm[idx] = cv * sigmoidf_(cv);
      }
      __syncthreads();
      const int cq = tid & 15, dg = tid >> 4;
      float acc[3][4];
#pragma unroll
      for (int s = 0; s < 3; ++s)
#pragma unroll
        for (int e = 0; e < 4; ++e) acc[s][e] = 0.f;
      const float* wp = p.ada_w + ((size_t)l * 1024 + dg * 64) * 9216 + e0 + cq * 4;
#pragma unroll 8
      for (int dd = 0; dd < 64; ++dd) {
        const float4 w = *(const float4*)(wp + (size_t)dd * 9216);
        const int d = dg * 64 + dd;
#pragma unroll
        for (int s = 0; s < 3; ++s) {
          const float sv = sm[s * 1024 + d];
          acc[s][0] += sv * w.x; acc[s][1] += sv * w.y; acc[s][2] += sv * w.z; acc[s][3] += sv * w.w;
        }
      }
      float* red = sm + 3072;
#pragma unroll
      for (int s = 0; s < 3; ++s)
#pragma unroll
        for (int e = 0; e < 4; ++e) red[(dg * 3 + s) * 64 + cq * 4 + e] = acc[s][e];
      __syncthreads();
      if (tid < 192) {
        const int set = tid >> 6, col = tid & 63;
        float sum = p.ada_b[l * 9216 + e0 + col];
#pragma unroll
        for (int g = 0; g < 16; ++g) sum += red[(g * 3 + set) * 64 + col];
        p.mod[((size_t)set * 4 + l) * 9216 + e0 + col] = sum;
      }
      __syncthreads();
    } else if (it < N_MOD + N_S5) {
      const int idx = (it - N_MOD) * 256 + tid;
      const int id = idx >> 12, g = (idx >> 6) & 63, n = idx & 63;
      const double lr = p.lam_re[idx], li = p.lam_im[idx];
      const double dt = exp((double)p.log_dt[id * 64 + g]);
      const double mag = exp(lr * dt);
      double sn, cs;
      dsincos(li * dt, sn, cs);
      const double abr = mag * cs, abi = mag * sn;
      const double den = lr * lr + li * li;
      const double fr = ((abr - 1.0) * lr + abi * li) / den;
      const double fi = (abi * lr - (abr - 1.0) * li) / den;
      p.s5ab[idx * 2] = (float)abr;
      p.s5ab[idx * 2 + 1] = (float)abi;
      bf16_t* bb = p.s5bbt + (size_t)(id * 64 + g) * 2048;
      bf16_t* cm = p.s5cmt + (size_t)(id * 64 + g) * 2048;
#pragma unroll
      for (int c = 0; c < 16; ++c) {
        const double br = p.b_re[(size_t)idx * 16 + c], bi = p.b_im[(size_t)idx * 16 + c];
        bb[n * 16 + c] = f2bf((float)(fr * br - fi * bi));
        bb[(64 + n) * 16 + c] = f2bf((float)(fr * bi + fi * br));
        const size_t ci = ((size_t)(id * 64 + g) * 16 + c) * 64 + n;
        cm[c * 128 + 2 * n] = f2bf(p.c_re[ci]);
        cm[c * 128 + 2 * n + 1] = f2bf(-p.c_im[ci]);
      }
    } else if (it < N_MOD + N_S5 + N_MISC) {
      if (it == N_MOD + N_S5 + 1) {
        for (int m = 0; m < 2; ++m) {
          uint4* z = (uint4*)(p.abint + ((size_t)m * 2816 + 2688) * 1024);
#pragma unroll 1
          for (int e = tid; e < 128 * 1024 / 8; e += 256) z[e] = make_uint4(0u, 0u, 0u, 0u);
        }
      } else
      for (int idx = tid; idx < 1024; idx += 256) {
        const int pos = idx >> 4, j = idx & 15;
        const double inv = exp(-(double)j * (9.210340371976184 / 16.0));
        double sn, cs;
        dsincos((double)pos * inv, sn, cs);
        p.rope[idx * 2] = (float)cs;
        p.rope[idx * 2 + 1] = (float)sn;
      }
      if (it == N_MOD + N_S5 && tid < 64) p.cnt[tid] = 0u;
    } else {
      conv_by_T(tid0, p, conv_early_T(it - (N_MOD + N_S5 + N_MISC)), sm);
    }
  }
}

DI void row_phase(const int tid0, const int vb, const int vg, const Params& p, int l, int sub, bool has_prev, bool has_next) {
  const int lane = tid0 & 63, wave = tid0 >> 6;
  int lp = l, sp = sub - 1;
  if (sub == 0) { lp = l - 1; sp = 2; }
  if (lp < 0) { lp = 0; sp = 0; }
  const int ln = has_next ? l : 0;
  const float wgt = (sp == 1) ? 1.0f : 0.5f;
  const int co = lane * 4;
  for (int rb = vb; rb < NTOK / 8; rb += vg) {
    const int row0 = rb * 8 + wave;
    const int set = row0 < 4096 ? 0 : 1 + ((row0 - 4096) >> 12);
    const float* gp = p.norm_post + (size_t)(lp * 3 + sp) * 1024;
    const float* gt = p.mod + (((size_t)set * 4 + lp) * 9 + sp * 3 + 2) * 1024;
    const float* pre = p.norm_pre + (size_t)(ln * 3 + sub) * 1024;
    const float* sh = p.mod + (((size_t)set * 4 + ln) * 9 + sub * 3 + 0) * 1024;
    f32x4 x[2][4], gpv[4], gtv[4], prv[4], shv[4], scv[4];
    uint2 yb[2][4];
#pragma unroll
    for (int q = 0; q < 2; ++q) {
      const int row = row0 + 4 * q;
      const float* xs = has_prev ? p.out + (size_t)row * 1024 : (row < 4096 ? p.x_prompt + (size_t)row * 1024 : p.x_sample + (size_t)(row - 4096) * 1024);
      const bf16_t* yr = (const bf16_t*)p.y + (size_t)row * 1024;
#pragma unroll
      for (int j = 0; j < 4; ++j) {
        x[q][j] = *(const f32x4*)(xs + j * 256 + co);
        if (has_prev) yb[q][j] = *(const uint2*)(yr + j * 256 + co);
      }
    }
#pragma unroll
    for (int j = 0; j < 4; ++j) {
      if (has_prev) { gpv[j] = *(const f32x4*)(gp + j * 256 + co); gtv[j] = *(const f32x4*)(gt + j * 256 + co); }
      if (has_next) { prv[j] = *(const f32x4*)(pre + j * 256 + co); shv[j] = *(const f32x4*)(sh + j * 256 + co); scv[j] = *(const f32x4*)(sh + 1024 + j * 256 + co); }
    }
#pragma unroll
    for (int q = 0; q < 2; ++q) {
      const int row = row0 + 4 * q;
      float* xr = p.out + (size_t)row * 1024;
      if (has_prev) {
        f32x4 yv[4];
        float ss = 0.f;
#pragma unroll
        for (int j = 0; j < 4; ++j) {
          yv[j] = f32x4{__uint_as_float(yb[q][j].x << 16), __uint_as_float(yb[q][j].x & 0xffff0000u), __uint_as_float(yb[q][j].y << 16), __uint_as_float(yb[q][j].y & 0xffff0000u)};
          ss += yv[j].x * yv[j].x + yv[j].y * yv[j].y + yv[j].z * yv[j].z + yv[j].w * yv[j].w;
        }
        ss = wave_sum(ss);
        const float rs = rsqrtf(ss * (1.f / 1024.f) + RMS_EPS) * wgt;
#pragma unroll
        for (int j = 0; j < 4; ++j) x[q][j] += gtv[j] * (yv[j] * rs * gpv[j]);
      }
#pragma unroll
      for (int j = 0; j < 4; ++j) *(f32x4*)(xr + j * 256 + co) = x[q][j];
      if (has_next) {
        float ss = 0.f;
#pragma unroll
        for (int j = 0; j < 4; ++j) ss += x[q][j].x * x[q][j].x + x[q][j].y * x[q][j].y + x[q][j].z * x[q][j].z + x[q][j].w * x[q][j].w;
        ss = wave_sum(ss);
        const float rs = rsqrtf(ss * (1.f / 1024.f) + RMS_EPS);
        bf16_t* hr = p.hb + (size_t)row * 1024;
#pragma unroll
        for (int j = 0; j < 4; ++j) {
          const f32x4 hv = x[q][j] * rs * prv[j] * (1.f + scv[j]) + shv[j];
          *(uint2*)(hr + j * 256 + co) = make_uint2(pack2(hv.x, hv.y), pack2(hv.z, hv.w));
        }
      }
    }
  }
}

enum { EPI_F32 = 0, EPI_SWIGLU = 1, EPI_GLU = 2, EPI_DECAY = 3, EPI_A = 4, EPI_Y = 5 };
struct GemmDesc {
  const bf16_t* A; const bf16_t* Bt; int lda, ldb, K, epi, ldc;
  float* C; bf16_t* Cb; const float* e0; const float* e1; float* o1; float* o2; const bf16_t* zin;
};

DI void store_pair_bf16(bf16_t* __restrict__ C, const int ld, const int row_i, const int col, const int odd, const float vi, const float vi1) {
  const float send = odd ? vi : vi1;
  const float recv = __int_as_float(__builtin_amdgcn_update_dpp(0, __float_as_int(send), 0xB1, 0xF, 0xF, true));
  const float keep = odd ? vi1 : vi;
  const float lo = odd ? recv : keep, hi = odd ? keep : recv;
  *(unsigned*)(C + (unsigned)((row_i + odd) * ld + (col & ~1))) = pack2(lo, hi);
}

DI void gemm_tile(const int tid0, const GemmDesc& d, int m0, int n0, const Params& p, char* smem) {
  const int tid = tid0, lane = tid & 63, wave = tid >> 6, wm = wave >> 2, wn = wave & 3, l32 = lane & 31, hh = lane >> 5;
  f32x16 acc[3][2];
#pragma unroll
  for (int a = 0; a < 3; ++a)
#pragma unroll
    for (int b = 0; b < 2; ++b)
#pragma unroll
      for (int i = 0; i < 16; ++i) acc[a][b][i] = 0.f;
  const int lrow = tid >> 3, kc = (tid & 7) ^ ((lrow >> 1) & 7);
  const bf16_t* ag = d.A + (size_t)(m0 + lrow) * d.lda + kc * 8;
  const bf16_t* bg = d.Bt + (size_t)(n0 + lrow) * d.ldb + kc * 8;
  const size_t a64 = (size_t)64 * d.lda, b64 = (size_t)64 * d.ldb;
  const int nk = d.K >> 6;
#define GEMM_GLDS(kt_, base_) do { \
    char* wb_ = (base_) + wave * 1024; \
    _Pragma("unroll") for (int j = 0; j < 3; ++j) __builtin_amdgcn_global_load_lds((const unsigned*)(ag + j * a64 + (kt_) * 64), (unsigned*)(wb_ + j * 8192), 16, 0, 0); \
    _Pragma("unroll") for (int j = 0; j < 4; ++j) __builtin_amdgcn_global_load_lds((const unsigned*)(bg + j * b64 + (kt_) * 64), (unsigned*)(wb_ + 24576 + j * 8192), 16, 0, 0); \
  } while (0)
  GEMM_GLDS(0, smem);
  asm volatile("s_waitcnt vmcnt(0)" ::: "memory");
  __syncthreads();
  const int sx = (l32 >> 1) & 7;
  const int offA = (wm * 96 + l32) * 128, offB = 24576 + (wn * 64 + l32) * 128;
  for (int kt = 0; kt < nk; ++kt) {
    const char* st = smem + (kt & 1) * HALF_LDS;
    if (kt + 1 < nk) GEMM_GLDS(kt + 1, smem + ((kt + 1) & 1) * HALF_LDS);
    bf16x8 af[2][3], bfr[2][2];
    {
      const int pos = ((0 * 2 + hh) ^ sx) << 4;
#pragma unroll
      for (int a = 0; a < 3; ++a) af[0][a] = *(const bf16x8*)(st + offA + a * 4096 + pos);
#pragma unroll
      for (int b = 0; b < 2; ++b) bfr[0][b] = *(const bf16x8*)(st + offB + b * 4096 + pos);
    }
#pragma unroll
    for (int ks = 0; ks < 4; ++ks) {
      if (ks < 3) {
        const int pos = (((ks + 1) * 2 + hh) ^ sx) << 4;
#pragma unroll
        for (int a = 0; a < 3; ++a) af[(ks + 1) & 1][a] = *(const bf16x8*)(st + offA + a * 4096 + pos);
#pragma unroll
        for (int b = 0; b < 2; ++b) bfr[(ks + 1) & 1][b] = *(const bf16x8*)(st + offB + b * 4096 + pos);
      }
#pragma unroll
      for (int a = 0; a < 3; ++a)
#pragma unroll
        for (int b = 0; b < 2; ++b) acc[a][b] = __builtin_amdgcn_mfma_f32_32x32x16_bf16(af[ks & 1][a], bfr[ks & 1][b], acc[a][b], 0, 0, 0);
      __builtin_amdgcn_sched_barrier(0);
    }
    asm volatile("s_waitcnt vmcnt(0)" ::: "memory");
    __syncthreads();
  }
  const int rbase = m0 + wm * 96 + 4 * hh;
  const int cbase = n0 + wn * 64 + l32;
  const int odd = l32 & 1;
  if (d.epi == EPI_F32) {
    float* __restrict__ C = d.C;
#pragma unroll
    for (int a = 0; a < 3; ++a)
#pragma unroll
      for (int b = 0; b < 2; ++b)
#pragma unroll
        for (int i = 0; i < 16; ++i) {
          const int row = rbase + a * 32 + 8 * (i >> 2) + (i & 3);
          C[(unsigned)(row * d.ldc + cbase + b * 32)] = acc[a][b][i];
        }
  } else if (d.epi == EPI_Y) {
    bf16_t* __restrict__ Cb = d.Cb;
#pragma unroll
    for (int a = 0; a < 3; ++a)
#pragma unroll
      for (int b = 0; b < 2; ++b)
#pragma unroll
        for (int i = 0; i < 16; i += 2) {
          const int row = rbase + a * 32 + 8 * (i >> 2) + (i & 3);
          store_pair_bf16(Cb, 1024, row, cbase + b * 32, odd, acc[a][b][i], acc[a][b][i + 1]);
        }
  } else if (d.epi == EPI_SWIGLU) {
    bf16_t* __restrict__ Cb = d.Cb;
    const int colo = ((n0 + wn * 64) >> 1) + l32;
#pragma unroll
    for (int a = 0; a < 3; ++a)
#pragma unroll
      for (int i = 0; i < 16; i += 2) {
        const int row = rbase + a * 32 + 8 * (i >> 2) + (i & 3);
        const float a1 = acc[a][0][i], a3 = acc[a][1][i], b1 = acc[a][0][i + 1], b3 = acc[a][1][i + 1];
        const float g0 = a1 * __builtin_amdgcn_rcpf(1.f + __expf(-a1)) * a3;
        const float g1 = b1 * __builtin_amdgcn_rcpf(1.f + __expf(-b1)) * b3;
        store_pair_bf16(Cb, 2816, row, colo, odd, g0, g1);
      }
  } else if (d.epi == EPI_GLU) {
    bf16_t* __restrict__ Cb = d.Cb;
    const bf16_t* __restrict__ zin = d.zin;
#pragma unroll
    for (int a = 0; a < 3; ++a)
#pragma unroll
      for (int b = 0; b < 2; ++b)
#pragma unroll
        for (int i = 0; i < 16; i += 2) {
          if ((i & 3) == 0) __builtin_amdgcn_sched_barrier(0);
          const int row = rbase + a * 32 + 8 * (i >> 2) + (i & 3);
          const unsigned o = (unsigned)(row * 1024 + cbase + b * 32);
          const float z0 = bf2f(zin[o]) * __builtin_amdgcn_rcpf(1.f + __expf(-acc[a][b][i]));
          const float z1 = bf2f(zin[o + 1024]) * __builtin_amdgcn_rcpf(1.f + __expf(-acc[a][b][i + 1]));
          store_pair_bf16(Cb, 1024, row, cbase + b * 32, odd, z0, z1);
        }
  } else if (d.epi == EPI_DECAY) {
    float* __restrict__ C = d.C;
#pragma unroll
    for (int a = 0; a < 3; ++a)
#pragma unroll
      for (int b = 0; b < 2; ++b) {
        const float w0 = d.e0[cbase + b * 32];
#pragma unroll
        for (int i = 0; i < 16; ++i) {
          if ((i & 3) == 0) __builtin_amdgcn_sched_barrier(0);
          const int row = rbase + a * 32 + 8 * (i >> 2) + (i & 3);
          const float xx = -(w0 + acc[a][b][i]);
          const float sp = fmaxf(xx, 0.f) + __logf(1.f + __expf(-fabsf(xx)));
          const float w = -sp - 0.5f;
          C[(unsigned)(row * 512 + cbase + b * 32)] = __expf(-__expf(w));
        }
      }
  } else {
    float* __restrict__ o1 = d.o1;
    float* __restrict__ o2 = d.o2;
    const float* __restrict__ kkp = p.kk;
    const float* __restrict__ krp = p.kraw;
#pragma unroll
    for (int a = 0; a < 3; ++a)
#pragma unroll
      for (int b = 0; b < 2; ++b) {
        const float a0v = d.e0[cbase + b * 32];
        const float kav = d.e1[cbase + b * 32];
#pragma unroll
        for (int i = 0; i < 16; ++i) {
          if ((i & 3) == 0) __builtin_amdgcn_sched_barrier(0);
          const int row = rbase + a * 32 + 8 * (i >> 2) + (i & 3);
          const unsigned o = (unsigned)(row * 512 + cbase + b * 32);
          const float av = __builtin_amdgcn_rcpf(1.f + __expf(-(a0v + acc[a][b][i])));
          o1[o] = kkp[o] * av;
          o2[o] = krp[o] * (1.f + (av - 1.f) * kav);
        }
      }
  }
}

enum { G_UP = 0, G_DOWN, G_ABIN, G_ABOUT, G_S5IN, G_GLU, G_S5OUT, G_LORA };

DI void gemm_phase(const int tid0, const Params& p, int kind, int l, int j, char* smem) {
  const int i = l >> 1;
  int N;
  switch (kind) {
    case G_UP: N = 5632; break;
    case G_ABIN: N = 2816; break;
    case G_LORA: N = 2560; break;
    default: N = 1024; break;
  }
  const int ntiles = 64 * (N >> 8);
  for (int tile = blockIdx.x; tile < ntiles; tile += gridDim.x) {
    const int mt = tile & 63;
    int nt = tile >> 6;
    GemmDesc d;
    d.lda = 1024; d.ldb = 1024; d.K = 1024; d.epi = EPI_F32; d.ldc = 1024;
    d.C = nullptr; d.Cb = nullptr; d.e0 = nullptr; d.e1 = nullptr; d.o1 = nullptr; d.o2 = nullptr; d.zin = nullptr;
    d.A = p.hb; d.Bt = nullptr;
    if (kind == G_UP) { d.Bt = p.w13t + (size_t)(l * 2 + j) * 5632 * 1024; d.epi = EPI_SWIGLU; d.Cb = p.g; }
    else if (kind == G_DOWN) { d.A = p.g; d.lda = 2816; d.Bt = p.w2t + (size_t)(l * 2 + j) * 1024 * 2816; d.ldb = 2816; d.K = 2816; d.epi = EPI_Y; d.Cb = (bf16_t*)p.y; }
    else if (kind == G_ABIN) { d.Bt = p.abint + (size_t)i * 2816 * 1024; d.C = p.pw; d.ldc = 2816; }
    else if (kind == G_ABOUT) { d.Bt = p.aboutt + (size_t)i * 1048576; d.epi = EPI_Y; d.Cb = (bf16_t*)p.y; }
    else if (kind == G_S5IN) { d.Bt = p.s5int + (size_t)i * 1048576; d.C = p.u; }
    else if (kind == G_GLU) { d.A = p.zb; d.Bt = p.s5glut + (size_t)i * 1048576; d.epi = EPI_GLU; d.zin = p.zb; d.Cb = p.z2b; }
    else if (kind == G_S5OUT) { d.A = p.z2b; d.Bt = p.s5outt + (size_t)i * 1048576; d.epi = EPI_Y; d.Cb = (bf16_t*)p.y; }
    else {
      const int which = nt >> 1; nt &= 1;
      d.lda = 384; d.ldb = 64; d.K = 64; d.ldc = 512;
      if (which < 2) { d.A = p.la + which * 64; d.Bt = p.wupt + (size_t)(i * 2 + which) * 32768; d.epi = EPI_DECAY; d.e0 = p.w0 + (i * 2 + which) * 512; d.C = p.pw + (size_t)(which * 3) * SZ512; }
      else if (which < 4) { const int dd = which - 2; d.A = p.la + 128 + dd * 64; d.Bt = p.aupt + (size_t)(i * 2 + dd) * 32768; d.epi = EPI_A; d.e0 = p.a0 + (i * 2 + dd) * 512; d.e1 = p.k_a + i * 512;
                         d.o1 = p.pw + (size_t)(dd * 3 + 1) * SZ512; d.o2 = p.pw + (size_t)(dd * 3 + 2) * SZ512; }
      else { d.A = p.la + 256; d.Bt = p.gupt + (size_t)i * 65536; d.ldb = 128; d.K = 128; d.C = p.gt; }
    }
    gemm_tile(tid0, d, mt * 192, nt * 256, p, smem);
  }
}

DI void prep_phase(const int tid0, const int vb, const int vg, const Params& p, int i) {
  const int tid = tid0, lane = tid & 63, wave = tid >> 6;
  constexpr int NROWB = NTOK / 4, NCACHE = 64;
  for (int it = vb; it < NROWB + NCACHE; it += vg) {
    if (it < NROWB) {
      const int row = it * 4 + wave;
      const bool isctx = row < 4096;
      int b, t, L;
      if (isctx) { b = row >> 8; t = row & 255; L = 256; } else { b = (row - 4096) >> 12; t = (row - 4096) & 4095; L = 4096; }
      const float* pr = p.pw + (size_t)row * 2816;
      const float qg = p.q_gain[i * 64 + lane], kg = p.k_gain[i * 64 + lane];
      float cs = 1.f, sn = 0.f;
      if (!isctx) {
        const int pos = (lane < 32) ? (t >> 6) : (t & 63);
        cs = p.rope[(pos * 16 + (lane & 15)) * 2];
        sn = p.rope[(pos * 16 + (lane & 15)) * 2 + 1];
        if (!(lane & 16)) sn = -sn;
      }
      float qx[8], kx[2], vx[2];
#pragma unroll
      for (int h = 0; h < 8; ++h) qx[h] = pr[h * 64 + lane];
#pragma unroll
      for (int kv = 0; kv < 2; ++kv) { kx[kv] = pr[512 + kv * 64 + lane]; vx[kv] = pr[640 + kv * 64 + lane]; }
      const float* pb = pr + 768;
      const bool hp = t > 0, hn = t < L - 1;
      float xs[30], xps[30], xns[30];
#pragma unroll
      for (int j = 0; j < 15; ++j) {
        const int c = j * 64 + lane;
        xs[j] = pb[c];
        xps[j] = hp ? pb[c - 2816] : 0.f;
        xns[j] = hn ? pb[c + 2816] : 0.f;
      }
#pragma unroll
      for (int h = 0; h < 8; ++h) {
        const float x = qx[h];
        const float ss = wave_sum(x * x);
        float xn = x * rsqrtf(ss * (1.f / 64.f) + RMS_EPS) * qg;
        const float xp = __shfl_xor(xn, 16);
        xn = xn * cs + xp * sn;
        p.qb[(size_t)row * 512 + h * 64 + lane] = f2bf(xn * QSCALE);
      }
#pragma unroll
      for (int kv = 0; kv < 2; ++kv) {
        const float x = kx[kv];
        const float ss = wave_sum(x * x);
        const float kn = x * rsqrtf(ss * (1.f / 64.f) + RMS_EPS) * kg;
        const float xp = __shfl_xor(kn, 16);
        const float kr = kn * cs + xp * sn;
        const float vv = vx[kv];
        if (isctx) {
          const size_t o = ((size_t)(b * 2 + i) * 256 + t) * 128 + kv * 64 + lane;
          p.out[OUT_NEWK + o] = kn;
          p.out[OUT_NEWV + o] = vv;
          p.kbc[((size_t)(b * 2 + kv) * 256 + t) * 64 + lane] = f2bf(kr);
          p.vtc[((size_t)(b * 2 + kv) * 64 + lane) * 256 + vperm(t)] = f2bf(vv);
        } else {
          p.kbl[((size_t)(b * 2 + kv) * 4352 + t) * 64 + lane] = f2bf(kr);
          p.vtl[((size_t)(b * 2 + kv) * 64 + lane) * 4352 + vperm(t)] = f2bf(vv);
        }
      }
      const float* mu = p.mu + i * 1920;
#pragma unroll
      for (int j = 0; j < 30; ++j) {
        if (j == 3) {
#pragma unroll
          for (int jj = 15; jj < 30; ++jj) {
            const int cc = jj * 64 + lane;
            xs[jj] = pb[cc];
            xps[jj] = hp ? pb[cc - 2816] : 0.f;
            xns[jj] = hn ? pb[cc + 2816] : 0.f;
          }
        }
        const int c = j * 64 + lane;
        const float x = xs[j];
        const float xp = xps[j];
        const float xn = xns[j];
        const float m = x + mu[c] * (0.5f * (xp + xn) - x);
        if (j < 8) p.r[(size_t)row * 512 + c] = m;
        else if (j < 16) {
          const size_t o = (size_t)row * 512 + c - 512;
          p.kraw[o] = m;
          const float kkv = m * p.k_k[i * 512 + c - 512];
          const float ss = wave_sum(kkv * kkv);
          p.kk[o] = kkv / fmaxf(sqrtf(ss), 1e-12f);
        } else if (j < 24) p.v[(size_t)row * 512 + c - 1024] = m;
        else if (j < 26) p.la[(size_t)row * 384 + 256 + (c - 1536)] = f2bf(sigmoidf_(m));
        else if (j < 28) p.la[(size_t)row * 384 + (j - 26) * 64 + lane] = f2bf(1.f - 2.f / (1.f + __expf(2.f * m)));
        else p.la[(size_t)row * 384 + 128 + (j - 28) * 64 + lane] = f2bf(m);
      }
    } else {
      const int base = (it - NROWB) * 1024;
#pragma unroll
      for (int e = 0; e < 4; ++e) {
        const int idx = base + e * 256 + tid;
        const int d = idx & 63, kv = (idx >> 6) & 1, pp = (idx >> 7) & 255, b = idx >> 15;
        const size_t ci = ((((size_t)b * 2 + i) * 256 + pp) * 2 + kv) * 64 + d;
        p.kbl[((size_t)(b * 2 + kv) * 4352 + 4096 + pp) * 64 + d] = f2bf(p.cache_k[ci]);
        p.vtl[((size_t)(b * 2 + kv) * 64 + d) * 4352 + 4096 + vperm(pp)] = f2bf(p.cache_v[ci]);
      }
    }
  }
}

DI void wkv_item(const int tid0, const Params& p, int i, bool isctx, int b, int h, int dir, int qr, char* smem, const bool do_comp, const bool do_load) {
  float* buf = (float*)smem;
  float* vb = buf + 2 * 5 * 1024;
  const int tid = tid0, lane = tid & 63, wave = tid >> 6, q = lane >> 4, j = lane & 15;
  const int L = isctx ? 256 : 4096;
  const int row0 = isctx ? b * 256 : 4096 + b * 4096;
  const int vrow = qr * 16 + wave * 4 + q;
  const float* Wd = p.pw + (size_t)(dir * 3) * SZ512;
  const float* KKA = Wd + SZ512;
  const float* KD = KKA + SZ512;
  float* ys = p.y + (size_t)dir * SZ512;
  f32x2 Sa = {0.f, 0.f}, Sb = {0.f, 0.f};
  const bool solo = do_comp != do_load;
  float* ypart0 = (float*)(smem + 43008) + wave * 1024;
  const size_t sidx = ((((size_t)b * 2 + i) * 2 + dir) * 8 + h) * 4096 + vrow * 64 + j * 4;
  if (!isctx && do_comp) {
    const float4 s = *(const float4*)(p.state_rwkv + sidx);
    Sa = f32x2{s.x, s.y}; Sb = f32x2{s.z, s.w};
  }
  const int nch = L >> 4;
  const int lstep = tid >> 4, lquad = tid & 15;
  const int vstep = (tid >> 2) & 15, vq4 = tid & 3;
  auto load_chunk = [&](int ck, f32x4 (&ls)[5], f32x4& lv) {
    const int s1 = ck * 16 + lstep;
    const int t = dir ? (L - 1 - s1) : s1;
    const size_t off = (size_t)(row0 + t) * 512 + h * 64 + lquad * 4;
    ls[0] = *(const f32x4*)(Wd + off); ls[1] = *(const f32x4*)(p.kk + off); ls[2] = *(const f32x4*)(KKA + off);
    ls[3] = *(const f32x4*)(KD + off); ls[4] = *(const f32x4*)(p.r + off);
    const int s2 = ck * 16 + vstep;
    const int t2 = dir ? (L - 1 - s2) : s2;
    lv = *(const f32x4*)(p.v + (size_t)(row0 + t2) * 512 + h * 64 + qr * 16 + vq4 * 4);
  };
  auto publish_chunk = [&](int bi, const f32x4 (&ls)[5], const f32x4& lv) {
    float* bn = buf + bi * 5120;
#pragma unroll
    for (int a = 0; a < 5; ++a) *(f32x4*)(bn + a * 1024 + lstep * 64 + lquad * 4) = ls[a];
    if (tid < 64) *(f32x4*)(vb + bi * 256 + vstep * 16 + vq4 * 4) = lv;
  };
  auto reduce_y = [&](const int cc, const float* yp) {
    const float* yr = yp + j * 64 + q * 16;
    const f32x4 y0 = *(const f32x4*)(yr), y1 = *(const f32x4*)(yr + 4), y2 = *(const f32x4*)(yr + 8), y3 = *(const f32x4*)(yr + 12);
    const f32x4 ysum = (y0 + y1) + (y2 + y3);
    const float yv = (ysum.x + ysum.y) + (ysum.z + ysum.w);
    const int sg = cc * 16 + j;
    const int t = dir ? (L - 1 - sg) : sg;
    ys[(size_t)(row0 + t) * 512 + h * 64 + vrow] = yv;
  };
  f32x4 lda[5], ldav, ldb[5], ldbv;
  if (do_load) load_chunk(0, lda, ldav);
  __syncthreads();
  if (do_load) {
    publish_chunk(0, lda, ldav);
    load_chunk(1, lda, ldav);
    load_chunk(2, ldb, ldbv);
  }
  __syncthreads();
  auto body = [&](const int c, f32x4 (&ls)[5], f32x4& lv) {
    const int cb = c & 1;
    float* ypart = ypart0 + (solo ? cb * 4096 : 0);
    float* ypw = ypart + lane;
    if (do_comp) {
    const float* bc = buf + cb * 5120 + j * 4;
    const float* vc = vb + cb * 256 + wave * 4 + q;
    f32x4 w4n = *(const f32x4*)(bc), k4n = *(const f32x4*)(bc + 1024), ka4n = *(const f32x4*)(bc + 2048),
          kd4n = *(const f32x4*)(bc + 3072), r4n = *(const f32x4*)(bc + 4096);
    float vvn = vc[0];
#pragma unroll 2
    for (int s4 = 0; s4 < 16; s4 += 4)
#pragma unroll
    for (int ss = 0; ss < 4; ++ss) {
      const int s = s4 + ss;
      const f32x4 w4 = w4n, k4 = k4n, ka4 = ka4n, kd4 = kd4n, r4 = r4n;
      const float vv = vvn;
      if (s < 15) {
        w4n = *(const f32x4*)(bc + (s + 1) * 64);
        k4n = *(const f32x4*)(bc + 1024 + (s + 1) * 64);
        ka4n = *(const f32x4*)(bc + 2048 + (s + 1) * 64);
        kd4n = *(const f32x4*)(bc + 3072 + (s + 1) * 64);
        r4n = *(const f32x4*)(bc + 4096 + (s + 1) * 64);
        vvn = vc[(s + 1) * 16];
      }
      const f32x2 ta_ = Sa * f32x2{w4.x, w4.y} + f32x2{kd4.x, kd4.y} * vv;
      const f32x2 tb_ = Sb * f32x2{w4.z, w4.w} + f32x2{kd4.z, kd4.w} * vv;
      f32x2 pt = Sa * f32x2{k4.x, k4.y};
      pt = Sb * f32x2{k4.z, k4.w} + pt;
      float pd = pt.x + pt.y;
      pd = allred16(pd);
      const float sa = -pd;
      Sa = f32x2{ka4.x, ka4.y} * sa + ta_;
      Sb = f32x2{ka4.z, ka4.w} * sa + tb_;
      f32x2 yt = Sa * f32x2{r4.x, r4.y};
      yt = Sb * f32x2{r4.z, r4.w} + yt;
      ypw[s * 64] = yt.x + yt.y;
    }
    if (!solo) {
      asm volatile("s_waitcnt lgkmcnt(0)" ::: "memory");
      __builtin_amdgcn_wave_barrier();
      reduce_y(c, ypart);
      asm volatile("s_waitcnt lgkmcnt(0)" ::: "memory");
      __builtin_amdgcn_wave_barrier();
    }
    }
    if (do_load) {
      if (c + 1 < nch) publish_chunk(cb ^ 1, ls, lv);
      if (c + 3 < nch) load_chunk(c + 3, ls, lv);
      if (solo && c > 0) reduce_y(c - 1, ypart0 + (cb ^ 1) * 4096);
    }
    __syncthreads();
  };
  for (int c = 0; c < nch; c += 2) {
    body(c, lda, ldav);
    body(c + 1, ldb, ldbv);
  }
  if (solo && do_load) reduce_y(nch - 1, ypart0 + ((nch - 1) & 1) * 4096);
  if (isctx && do_comp) *(float4*)(p.out + OUT_RWKV + sidx) = make_float4(Sa.x, Sa.y, Sb.x, Sb.y);
}

DI void attn_item(const int tid0, const Params& p, int qrow0, const bf16_t* __restrict__ kb, const bf16_t* __restrict__ vt, int T, int kv, char* smem) {
  bf16_t* Ks = (bf16_t*)smem;
  bf16_t* Vs = Ks + 64 * 72;
  const int tid = tid0, lane = tid & 63, wave = tid >> 6, l32 = lane & 31, hh = lane >> 5;
  const int head = kv * 4 + wave;
  bf16x8 qf[4];
#pragma unroll
  for (int ks = 0; ks < 4; ++ks) qf[ks] = *(const bf16x8*)(p.qb + (size_t)(qrow0 + l32) * 512 + head * 64 + ks * 16 + hh * 8);
  f32x16 O[2];
#pragma unroll
  for (int dt = 0; dt < 2; ++dt)
#pragma unroll
    for (int e = 0; e < 16; ++e) O[dt][e] = 0.f;
  float m_run = -1e30f, lsum = 0.f;
  const int nkt = T >> 6;
  const int lr = tid >> 3, lc = (tid & 7) * 8;
  u32x4 rk[2], rv[2];
#pragma unroll
  for (int jj = 0; jj < 2; ++jj) {
    rk[jj] = *(const u32x4*)(kb + (size_t)(lr + 32 * jj) * 64 + lc);
    rv[jj] = *(const u32x4*)(vt + (size_t)(lr + 32 * jj) * T + lc);
  }
  for (int kt = 0; kt < nkt; ++kt) {
    __syncthreads();
#pragma unroll
    for (int jj = 0; jj < 2; ++jj) {
      *(u32x4*)(Ks + (lr + 32 * jj) * 72 + lc) = rk[jj];
      *(u32x4*)(Vs + (lr + 32 * jj) * 72 + lc) = rv[jj];
    }
    __syncthreads();
    if (kt + 1 < nkt) {
#pragma unroll
      for (int jj = 0; jj < 2; ++jj) {
        rk[jj] = *(const u32x4*)(kb + (size_t)((kt + 1) * 64 + lr + 32 * jj) * 64 + lc);
        rv[jj] = *(const u32x4*)(vt + (size_t)(lr + 32 * jj) * T + (kt + 1) * 64 + lc);
      }
    }
    f32x16 S[2];
#pragma unroll
    for (int m = 0; m < 2; ++m) {
#pragma unroll
      for (int e = 0; e < 16; ++e) S[m][e] = 0.f;
#pragma unroll
      for (int ks = 0; ks < 4; ++ks) {
        const bf16x8 a = *(const bf16x8*)(Ks + (32 * m + l32) * 72 + ks * 16 + hh * 8);
        S[m] = __builtin_amdgcn_mfma_f32_32x32x16_bf16(a, qf[ks], S[m], 0, 0, 0);
      }
    }
    float mx = S[0][0];
#pragma unroll
    for (int e = 1; e < 16; ++e) mx = fmaxf(mx, S[0][e]);
#pragma unroll
    for (int e = 0; e < 16; ++e) mx = fmaxf(mx, S[1][e]);
    mx = fmaxf(mx, __shfl_xor(mx, 32));
    const float mnew = fmaxf(m_run, mx);
    const float alpha = __builtin_amdgcn_exp2f(m_run - mnew);
    m_run = mnew;
    float ls = 0.f;
#pragma unroll
    for (int m = 0; m < 2; ++m)
#pragma unroll
      for (int e = 0; e < 16; ++e) {
        const float pv = __builtin_amdgcn_exp2f(S[m][e] - mnew);
        S[m][e] = pv;
        ls += pv;
      }
    lsum = lsum * alpha + ls;
#pragma unroll
    for (int dt = 0; dt < 2; ++dt)
#pragma unroll
      for (int e = 0; e < 16; ++e) O[dt][e] *= alpha;
#pragma unroll
    for (int ks2 = 0; ks2 < 4; ++ks2) {
      const int m = ks2 >> 1, u = ks2 & 1;
      uint4 pk;
      pk.x = pack2(S[m][8 * u + 0], S[m][8 * u + 1]);
      pk.y = pack2(S[m][8 * u + 2], S[m][8 * u + 3]);
      pk.z = pack2(S[m][8 * u + 4], S[m][8 * u + 5]);
      pk.w = pack2(S[m][8 * u + 6], S[m][8 * u + 7]);
      const bf16x8 pb = __builtin_bit_cast(bf16x8, pk);
#pragma unroll
      for (int dt = 0; dt < 2; ++dt) {
        const bf16x8 a = *(const bf16x8*)(Vs + (32 * dt + l32) * 72 + ks2 * 16 + hh * 8);
        O[dt] = __builtin_amdgcn_mfma_f32_32x32x16_bf16(a, pb, O[dt], 0, 0, 0);
      }
    }
  }
  lsum += __shfl_xor(lsum, 32);
  const float inv = 1.f / lsum;
  bf16_t* orow = p.hb + (size_t)(qrow0 + l32) * 1024 + head * 64;
#pragma unroll
  for (int dt = 0; dt < 2; ++dt)
#pragma unroll
    for (int i4 = 0; i4 < 4; ++i4) {
      const int d = 32 * dt + 8 * i4 + 4 * hh;
      *(uint2*)(orow + d) = make_uint2(pack2(O[dt][4 * i4] * inv, O[dt][4 * i4 + 1] * inv), pack2(O[dt][4 * i4 + 2] * inv, O[dt][4 * i4 + 3] * inv));
    }
}

DI void scanattn_phase(const int tidfull, const int ci, const Params& p, char* smem_full) {
  __shared__ int s_item;
  const int i = ci & 7;
  const int half = tidfull >> 8, tid0 = tidfull & 255;
  char* smem = smem_full + half * HALF_LDS;
  constexpr int TOTAL = 1024;
  while (true) {
    __syncthreads();
    if (tidfull == 0) s_item = (int)atomicAdd(p.cnt + ci, 1u);
    __syncthreads();
    const int pid = s_item;
    if (pid >= TOTAL + (i == 0 ? N_CONV_LATE_A / 2 : N_CONV_LATE_B / 2)) break;
    if (pid >= TOTAL) {
      const int qq = (pid - TOTAL) * 2 + half;
      conv_by_T(tid0, p, i == 0 ? conv_lateA_T(qq) : conv_lateB_T(qq), (float*)smem);
      continue;
    }
    if (pid < 128) {
      const int id = pid;
      wkv_item(tid0, p, i, false, id >> 6, (id >> 3) & 7, (id >> 2) & 1, id & 3, smem_full, half == 0, half == 1);
    } else if (pid < 384) {
      const int a = (pid - 128) * 2 + half, b = a >> 8, kv = (a >> 7) & 1, qt = a & 127;
      attn_item(tid0, p, 4096 + b * 4096 + qt * 32, p.kbl + (size_t)(b * 2 + kv) * 4352 * 64, p.vtl + (size_t)(b * 2 + kv) * 64 * 4352, 4352, kv, smem);
    } else if (pid < 896) {
      const int a = (pid - 384) * 2 + half;
      wkv_item(tid0, p, i, true, a >> 6, (a >> 3) & 7, (a >> 2) & 1, a & 3, smem, true, true);
    } else {
      const int a = (pid - 896) * 2 + half, b = a >> 4, kv = (a >> 3) & 1, qt = a & 7;
      attn_item(tid0, p, b * 256 + qt * 32, p.kbc + (size_t)(b * 2 + kv) * 256 * 64, p.vtc + (size_t)(b * 2 + kv) * 64 * 256, 256, kv, smem);
    }
  }
}

DI void fin_phase(const int tid0, const int vb, const int vg, const Params& p, int i) {
  const int lane = tid0 & 63, wave = tid0 >> 6;
  const float* KDf = p.pw + (size_t)2 * SZ512;
  const float* KDb = p.pw + (size_t)5 * SZ512;
  float rk[8], lw[8], lb[8];
#pragma unroll
  for (int h = 0; h < 8; ++h) {
    const int c = i * 512 + h * 64 + lane;
    rk[h] = p.r_k[c]; lw[h] = p.ln_w[c]; lb[h] = p.ln_b[c];
  }
  for (int rb = vb; rb < NTOK / 4; rb += vg) {
    const int row = rb * 4 + wave;
    const size_t o0 = (size_t)row * 512 + lane;
    float r[8], vv[8], kd[8], ya[8], yb[8], gt[8];
#pragma unroll
    for (int h = 0; h < 8; ++h) {
      const size_t o = o0 + h * 64;
      r[h] = p.r[o]; vv[h] = p.v[o]; kd[h] = KDf[o] + KDb[o]; ya[h] = p.y[o]; yb[h] = p.y[SZ512 + o]; gt[h] = p.gt[o];
    }
    float ov[8];
#pragma unroll
    for (int h = 0; h < 8; ++h) {
      const float bsum = wave_sum(r[h] * rk[h] * kd[h]);
      const float yv = ya[h] + yb[h] + bsum * vv[h];
      const float mean = wave_sum(yv) * (1.f / 64.f);
      const float dl = yv - mean;
      const float var = wave_sum(dl * dl) * (1.f / 64.f);
      const float yn = dl * rsqrtf(var + 64e-5f);
      ov[h] = (yn * lw[h] + lb[h]) * gt[h];
    }
#pragma unroll
    for (int h = 0; h < 8; ++h) p.hb[(size_t)row * 1024 + 512 + h * 64 + lane] = f2bf(ov[h]);
  }
}

DI void s5_phase(const int tid0, const int vb, const int vg, const Params& p, int i, char* smem) {
  const int tid = tid0, lane = tid & 63, wave = tid >> 6, l32 = lane & 31, hh = lane >> 5, l16 = lane & 15, q16 = lane >> 4;
  bf16_t* Hs = (bf16_t*)smem + wave * (2 * 16 * 136);
  constexpr int NUNIT = 1152;
  for (int slot = vb; slot < NUNIT / 4; slot += vg) {
    const int ub = slot < 64 ? ((slot & 1) ? 32 + (slot >> 1) : (slot >> 1)) : slot;
    const int unit = ub * 4 + wave;
    bool isctx; int pair, g, dir;
    if (unit < 128) { isctx = false; pair = 0; g = unit >> 1; dir = unit & 1; }
    else { const int a = unit - 128; isctx = true; pair = a >> 7; g = (a >> 1) & 63; dir = a & 1; }
    const int L = isctx ? 256 : 4096;
    const int bme = pair * 2 + hh;
    const int id = i * 2 + dir;
    const int a_bsel = (l32 >> 2) & 1, a_tok = 4 * (l32 >> 3) + (l32 & 3);
    const int a_b = pair * 2 + a_bsel;
    const size_t a_row0 = isctx ? (size_t)a_b * 256 : 4096 + (size_t)a_b * 4096;
    const float* ua = p.u + a_row0 * 1024 + g * 16 + hh * 8;
    bf16x8 bbf[4];
#pragma unroll
    for (int nt = 0; nt < 4; ++nt) bbf[nt] = *(const bf16x8*)(p.s5bbt + (size_t)(id * 64 + g) * 2048 + (nt * 32 + l32) * 16 + hh * 8);
    bf16x8 cmf[4];
#pragma unroll
    for (int ks = 0; ks < 4; ++ks) cmf[ks] = *(const bf16x8*)(p.s5cmt + (size_t)(id * 64 + g) * 2048 + l16 * 128 + ks * 32 + q16 * 8);
    const float2 ab0 = *(const float2*)(p.s5ab + ((size_t)id * 4096 + g * 64 + l32) * 2);
    const float2 ab1 = *(const float2*)(p.s5ab + ((size_t)id * 4096 + g * 64 + 32 + l32) * 2);
    float hr0 = 0.f, hi0 = 0.f, hr1 = 0.f, hi1 = 0.f;
    const size_t sbase = ((((size_t)bme * 2 + i) * 2 + dir) * 2) * 4096 + g * 64 + l32;
    if (!isctx) {
      hr0 = p.state_s5[sbase]; hi0 = p.state_s5[sbase + 4096];
      hr1 = p.state_s5[sbase + 32]; hi1 = p.state_s5[sbase + 4096 + 32];
    }
    float* yout = p.ysd + (size_t)dir * NTOK * 1024;
    const int nch = L >> 4;
    f32x4 pa0, pa1, pb0, pb1, pc0 = {0.f, 0.f, 0.f, 0.f}, pc1 = {0.f, 0.f, 0.f, 0.f};
    {
      const int t00 = dir ? (L - 16) : 0;
      pa0 = *(const f32x4*)(ua + (size_t)(t00 + a_tok) * 1024);
      pa1 = *(const f32x4*)(ua + (size_t)(t00 + a_tok) * 1024 + 4);
      const int t01 = dir ? (L - 32) : 16;
      pb0 = *(const f32x4*)(ua + (size_t)(t01 + a_tok) * 1024);
      pb1 = *(const f32x4*)(ua + (size_t)(t01 + a_tok) * 1024 + 4);
    }
    for (int c = 0; c < nch; ++c) {
      const int t0 = dir ? (L - 16 * (c + 1)) : 16 * c;
      if (c + 2 < nch) {
        const int t2 = dir ? (L - 16 * (c + 3)) : 16 * (c + 2);
        pc0 = *(const f32x4*)(ua + (size_t)(t2 + a_tok) * 1024);
        pc1 = *(const f32x4*)(ua + (size_t)(t2 + a_tok) * 1024 + 4);
      }
      const f32x4 u0 = pa0, u1 = pa1;
      pa0 = pb0; pa1 = pb1; pb0 = pc0; pb1 = pc1;
      uint4 up;
      up.x = pack2(u0.x, u0.y); up.y = pack2(u0.z, u0.w); up.z = pack2(u1.x, u1.y); up.w = pack2(u1.z, u1.w);
      const bf16x8 af = __builtin_bit_cast(bf16x8, up);
      f32x16 bu[4];
#pragma unroll
      for (int nt = 0; nt < 4; ++nt) {
#pragma unroll
        for (int e = 0; e < 16; ++e) bu[nt][e] = 0.f;
        bu[nt] = __builtin_amdgcn_mfma_f32_32x32x16_bf16(af, bbf[nt], bu[nt], 0, 0, 0);
      }
      unsigned* hrow = (unsigned*)(Hs + hh * (16 * 136)) + l32;
      if (dir == 0) {
#pragma unroll
        for (int e = 0; e < 16; ++e) {
          const float nr0 = ab0.x * hr0 - ab0.y * hi0 + bu[0][e];
          const float ni0 = ab0.x * hi0 + ab0.y * hr0 + bu[2][e];
          const float nr1 = ab1.x * hr1 - ab1.y * hi1 + bu[1][e];
          const float ni1 = ab1.x * hi1 + ab1.y * hr1 + bu[3][e];
          hr0 = nr0; hi0 = ni0; hr1 = nr1; hi1 = ni1;
          hrow[e * 68] = pack2(hr0, hi0); hrow[e * 68 + 32] = pack2(hr1, hi1);
        }
      } else {
#pragma unroll
        for (int e = 15; e >= 0; --e) {
          const float nr0 = ab0.x * hr0 - ab0.y * hi0 + bu[0][e];
          const float ni0 = ab0.x * hi0 + ab0.y * hr0 + bu[2][e];
          const float nr1 = ab1.x * hr1 - ab1.y * hi1 + bu[1][e];
          const float ni1 = ab1.x * hi1 + ab1.y * hr1 + bu[3][e];
          hr0 = nr0; hi0 = ni0; hr1 = nr1; hi1 = ni1;
          hrow[e * 68] = pack2(hr0, hi0); hrow[e * 68 + 32] = pack2(hr1, hi1);
        }
      }
      __builtin_amdgcn_fence(__ATOMIC_RELEASE, "wavefront");
      asm volatile("s_waitcnt lgkmcnt(0)" ::: "memory");
      __builtin_amdgcn_wave_barrier();
      f32x4 yt[2];
#pragma unroll
      for (int mt = 0; mt < 2; ++mt) {
        yt[mt][0] = 0.f; yt[mt][1] = 0.f; yt[mt][2] = 0.f; yt[mt][3] = 0.f;
#pragma unroll
        for (int ks = 0; ks < 4; ++ks) {
          const bf16x8 a = *(const bf16x8*)(Hs + mt * (16 * 136) + l16 * 136 + ks * 32 + q16 * 8);
          yt[mt] = __builtin_amdgcn_mfma_f32_16x16x32_bf16(a, cmf[ks], yt[mt], 0, 0, 0);
        }
      }
      asm volatile("s_waitcnt lgkmcnt(0)" ::: "memory");
      __builtin_amdgcn_wave_barrier();
#pragma unroll
      for (int mt = 0; mt < 2; ++mt) {
        const int bb_ = pair * 2 + mt;
        const size_t r0 = isctx ? (size_t)bb_ * 256 : 4096 + (size_t)bb_ * 4096;
#pragma unroll
        for (int rr = 0; rr < 4; ++rr) yout[(r0 + t0 + 4 * q16 + rr) * 1024 + g * 16 + l16] = yt[mt][rr];
      }
    }
    if (isctx) {
      float* so = p.out + OUT_S5 + sbase;
      so[0] = hr0; so[4096] = hi0; so[32] = hr1; so[4096 + 32] = hi1;
    }
  }
}

DI void s5post_phase(const int tid0, const int vb, const int vg, const Params& p, int i) {
  const size_t total4 = (size_t)NTOK * 1024 / 4;
  const float* y0 = p.ysd;
  const float* y1 = p.ysd + (size_t)NTOK * 1024;
  for (size_t idx = (size_t)vb * 256 + tid0; idx < total4; idx += (size_t)vg * 256) {
    const float4 a = *(const float4*)(y0 + idx * 4);
    const float4 b = *(const float4*)(y1 + idx * 4);
    const float4 uu = *(const float4*)(p.u + idx * 4);
    const int col = (int)((idx * 4) & 1023);
    const float4 dd = *(const float4*)(p.s5_d + i * 1024 + col);
    float z[4] = {a.x + b.x + dd.x * uu.x, a.y + b.y + dd.y * uu.y, a.z + b.z + dd.z * uu.z, a.w + b.w + dd.w * uu.w};
#pragma unroll
    for (int e = 0; e < 4; ++e) {
      const float x = z[e];
      const float inner = 0.7978845608028654f * (x + 0.044715f * x * x * x);
      const float th = 1.f - 2.f / (1.f + __expf(2.f * inner));
      z[e] = 0.5f * x * (1.f + th);
    }
    *(uint2*)(p.zb + idx * 4) = make_uint2(pack2(z[0], z[1]), pack2(z[2], z[3]));
  }
}

#define XB_TMO      128
#define XB_XCNT(j)  (256  + 64 * (j))
#define XB_XSUB(j)  (1280 + 64 * (j))
#define XB_XGEN(j)  (2304 + 64 * (j))
#define XB_TOP      3328
#define XB_TOPGEN   3392
#define XCD_BAR_WORDS 3456
#define XB_SPIN_CAP (1u << 18)
#define LAS __attribute__((address_space(3)))

__device__ __forceinline__ unsigned xb_ld(unsigned* p)              { return __hip_atomic_load(p, __ATOMIC_RELAXED, __HIP_MEMORY_SCOPE_AGENT); }
__device__ __forceinline__ unsigned xb_add(unsigned* p, unsigned v) { return __hip_atomic_fetch_add(p, v, __ATOMIC_RELAXED, __HIP_MEMORY_SCOPE_AGENT); }
__device__ __forceinline__ unsigned xb_xcc_id() { return (unsigned)__builtin_amdgcn_s_getreg((3 << 11) | 20) & 0xFu; }
#define XB_SPIN(cond, bar) do { unsigned _sp = 0; while (cond) { __builtin_amdgcn_s_sleep(1); \
    if ((++_sp & 255u) == 0u) { if (xb_ld(&(bar)[XB_TMO])) break; if (_sp > XB_SPIN_CAP) { atomicAdd(&(bar)[XB_TMO], 1u); break; } } } } while (0)

struct XcdBarrier {
    unsigned* bar; unsigned x;
    volatile LAS unsigned* st;
};

__device__ __forceinline__ XcdBarrier xcd_barrier_post(unsigned* bar, volatile LAS unsigned* st) {
    XcdBarrier b; b.bar = bar; b.x = xb_xcc_id(); b.st = st;
    if (threadIdx.x == 0) (void)xb_add(&bar[XB_XCNT(b.x)], 1u);
    return b;
}
__device__ __forceinline__ void xcd_barrier_complete(unsigned* bar, unsigned x, unsigned& nloc, unsigned& nx) {
    const unsigned G = gridDim.x * gridDim.y * gridDim.z;
    unsigned sum, cnt, mine, sp = 0u;
    for (;;) {
        sum = 0u; cnt = 0u; mine = 0u;
#pragma unroll
        for (unsigned j = 0; j < 16; ++j) { const unsigned c = xb_ld(&bar[XB_XCNT(j)]); sum += c; cnt += (c > 0u) ? 1u : 0u; mine = (j == x) ? c : mine; }
        if (sum == G) break;
        __builtin_amdgcn_s_sleep(1);
        if ((++sp & 255u) == 0u) { if (xb_ld(&bar[XB_TMO])) break; if (sp > XB_SPIN_CAP) { atomicAdd(&bar[XB_TMO], 1u); break; } }
    }
    nloc = mine > 0u ? mine : 1u; nx = cnt > 0u ? cnt : 1u;
}

__device__ __forceinline__ void xcd_barrier(const XcdBarrier& b) {
    asm volatile("s_waitcnt vmcnt(0)" ::: "memory");
    __syncthreads();
    if (threadIdx.x == 0) {
        unsigned* bar = b.bar;
        __builtin_amdgcn_s_waitcnt(0);
        unsigned nloc = b.st[0], nx = b.st[1];
        if (nloc == 0u) { xcd_barrier_complete(bar, b.x, nloc, nx); b.st[0] = nloc; b.st[1] = nx; }
        const unsigned old = xb_add(&bar[XB_XSUB(b.x)], 1u);
        const unsigned gen = old / nloc;
        if (old + 1u == (gen + 1u) * nloc) {
            __builtin_amdgcn_fence(__ATOMIC_RELEASE, "agent");
            asm volatile("s_waitcnt vmcnt(0)" ::: "memory");
            const unsigned og = xb_add(&bar[XB_TOP], 1u);
            const unsigned tg = og / nx;
            if (og + 1u == (tg + 1u) * nx) xb_add(&bar[XB_TOPGEN], 1u);
            else XB_SPIN(xb_ld(&bar[XB_TOPGEN]) == tg, bar);
            __builtin_amdgcn_fence(__ATOMIC_ACQUIRE, "agent");
            xb_add(&bar[XB_XGEN(b.x)], 1u);
            asm volatile("s_waitcnt vmcnt(0)" ::: "memory");
        } else {
            XB_SPIN(xb_ld(&bar[XB_XGEN(b.x)]) == gen, bar);
            __builtin_amdgcn_fence(__ATOMIC_ACQUIRE, "agent");
            asm volatile("s_waitcnt vmcnt(0)" ::: "memory");
        }
    }
    __syncthreads();
}


DI void grid_barrier(unsigned* bar, unsigned target) {
  asm volatile("s_waitcnt vmcnt(0)" ::: "memory");
  __syncthreads();
  if (threadIdx.x == 0) {
    __builtin_amdgcn_fence(__ATOMIC_RELEASE, "agent");
    asm volatile("s_waitcnt vmcnt(0)" ::: "memory");
    __hip_atomic_fetch_add(bar, 1u, __ATOMIC_RELAXED, __HIP_MEMORY_SCOPE_AGENT);
    while (__hip_atomic_load(bar, __ATOMIC_RELAXED, __HIP_MEMORY_SCOPE_AGENT) < target) __builtin_amdgcn_s_sleep(1);
    __builtin_amdgcn_fence(__ATOMIC_ACQUIRE, "agent");
    asm volatile("s_waitcnt vmcnt(0)" ::: "memory");
  }
  __syncthreads();
}

__global__ void __launch_bounds__(512) mega(Params p, int pb, int pe) {
  extern __shared__ __attribute__((aligned(16))) char smem[];
  cg::grid_group grid = cg::this_grid();
  unsigned nbar = 0;
  __shared__ uint4 xb_words;
  if (threadIdx.x == 0) xb_words = make_uint4(0u, 0u, 0u, 0u);
  __syncthreads();
  XcdBarrier xb = xcd_barrier_post(p.xbar, (volatile LAS unsigned*)&xb_words);
  for (int ph = pb; ph < pe; ++ph) {
    int op = 0, l = 0, gk = 0, gj = 0, rsub = 0;
    bool hprev = true, hnext = true;
    if (ph == 0) op = 0;
    else if (ph == NPHASE - 1) { op = 1; l = 4; rsub = 0; hnext = false; }
    else {
      const int q = ph - 1, lp = q / 25, r = q % 25;
      const bool even = r < 13;
      l = even ? 2 * lp : 2 * lp + 1;
      const int st = even ? r : r - 13;
      const int nmix = even ? 6 : 5;
      if (st == 0) { op = 1; rsub = 0; hprev = l > 0; }
      else if (st == 1) { op = 2; gk = G_UP; gj = 0; }
      else if (st == 2) { op = 2; gk = G_DOWN; gj = 0; }
      else if (st == 3) { op = 1; rsub = 1; }
      else if (st == 4 + nmix) { op = 1; rsub = 2; }
      else if (st == 5 + nmix) { op = 2; gk = G_UP; gj = 1; }
      else if (st == 6 + nmix) { op = 2; gk = G_DOWN; gj = 1; }
      else if (even) {
        if (st == 4) { op = 2; gk = G_ABIN; }
        else if (st == 5) op = 3;
        else if (st == 6) { op = 2; gk = G_LORA; }
        else if (st == 7) op = 4;
        else if (st == 8) op = 5;
        else { op = 2; gk = G_ABOUT; }
      } else {
        if (st == 4) { op = 2; gk = G_S5IN; }
        else if (st == 5) op = 6;
        else if (st == 6) op = 7;
        else if (st == 7) { op = 2; gk = G_GLU; }
        else { op = 2; gk = G_S5OUT; }
      }
    }
    const int i = l >> 1;
#ifdef DUPMASK
    const int nrep = ((DUPMASK >> op) & 1) ? 2 : 1;
#else
    const int nrep = 1;
#endif
    for (int rep = 0; rep < nrep; ++rep) {
    if (rep) grid.sync();
    int tidf = (int)__builtin_amdgcn_workitem_id_x();
    asm volatile("" : "+v"(tidf));
    const int half = tidf >> 8, tidr = tidf & 255;
    const int vb = blockIdx.x * 2 + half, vg = gridDim.x * 2;
    char* hsm = smem + half * HALF_LDS;
    switch (op) {
      case 0: init_phase(tidr, vb, vg, p, hsm); break;
      case 1: row_phase(tidr, vb, vg, p, l, rsub, hprev, hnext); break;
      case 2: gemm_phase(tidf, p, gk, l, gj, smem); break;
      case 3: prep_phase(tidr, vb, vg, p, i); break;
      case 4: scanattn_phase(tidf, i + 8 * rep, p, smem); break;
      case 5: fin_phase(tidr, vb, vg, p, i); break;
      case 6: s5_phase(tidr, vb, vg, p, i, hsm); break;
      default: s5post_phase(tidr, vb, vg, p, i); break;
    }
    }
    if (pe - pb > 1 && ph + 1 < pe) {
      if (pe > NPHASE) grid.sync();
      xcd_barrier(xb);
    }
  }
}

extern "C" void kernel_launch(void* const* d_in, const int* in_sizes, int n_in, void* d_out, int out_size, void* d_ws, size_t ws_size, hipStream_t stream) {
  Params p{};
  const float** pf = (const float**)&p;
  for (int k = 0; k < 41; ++k) pf[k] = (const float*)d_in[k];
  p.out = (float*)d_out;
  char* ws = (char*)d_ws;
  size_t off = 0;
  auto alloc = [&](size_t bytes) { char* r = ws + off; off += (bytes + 255) & ~(size_t)255; return r; };
  p.w13t = (bf16_t*)alloc((size_t)8 * 5632 * 1024 * 2);
  p.w2t = (bf16_t*)alloc((size_t)8 * 1024 * 2816 * 2);
  p.abint = (bf16_t*)alloc((size_t)2 * 2816 * 1024 * 2);
  p.aboutt = (bf16_t*)alloc((size_t)2 * 1048576 * 2);
  p.s5int = (bf16_t*)alloc((size_t)2 * 1048576 * 2);
  p.s5glut = (bf16_t*)alloc((size_t)2 * 1048576 * 2);
  p.s5outt = (bf16_t*)alloc((size_t)2 * 1048576 * 2);
  p.wupt = (bf16_t*)alloc((size_t)4 * 32768 * 2);
  p.aupt = (bf16_t*)alloc((size_t)4 * 32768 * 2);
  p.gupt = (bf16_t*)alloc((size_t)2 * 65536 * 2);
  p.mod = (float*)alloc((size_t)3 * 4 * 9216 * 4);
  p.rope = (float*)alloc(8192);
  p.s5ab = (float*)alloc((size_t)16384 * 2 * 4);
  p.s5bbt = (bf16_t*)alloc((size_t)4 * 64 * 2048 * 2);
  p.s5cmt = (bf16_t*)alloc((size_t)4 * 64 * 2048 * 2);
  p.cnt = (unsigned*)alloc(256);
  p.xbar = (unsigned*)alloc((size_t)XCD_BAR_WORDS * 4);
  p.hb = (bf16_t*)alloc((size_t)NTOK * 1024 * 2);
  p.y = (float*)alloc((size_t)NTOK * 1024 * 4);
  const size_t offB = off;
  p.g = (bf16_t*)alloc((size_t)NTOK * 2816 * 2);
  off = offB;
  p.pw = (float*)alloc((size_t)6 * SZ512 * 4);
  p.qb = (bf16_t*)alloc((size_t)NTOK * 512 * 2);
  p.kbc = (bf16_t*)alloc((size_t)16 * 2 * 256 * 64 * 2);
  p.kbl = (bf16_t*)alloc((size_t)2 * 2 * 4352 * 64 * 2);
  p.vtc = (bf16_t*)alloc((size_t)16 * 2 * 256 * 64 * 2);
  p.vtl = (bf16_t*)alloc((size_t)2 * 2 * 4352 * 64 * 2);
  p.r = (float*)alloc(SZ512 * 4);
  p.kk = (float*)alloc(SZ512 * 4);
  p.v = (float*)alloc(SZ512 * 4);
  p.kraw = (float*)alloc(SZ512 * 4);
  p.la = (bf16_t*)alloc((size_t)NTOK * 384 * 2);
  p.gt = (float*)alloc(SZ512 * 4);
  const size_t endEven = off;
  off = offB;
  p.u = (float*)alloc((size_t)NTOK * 1024 * 4);
  p.ysd = (float*)alloc((size_t)2 * NTOK * 1024 * 4);
  p.zb = (bf16_t*)alloc((size_t)NTOK * 1024 * 2);
  p.z2b = (bf16_t*)alloc((size_t)NTOK * 1024 * 2);
  const size_t endOdd = off;
  const size_t need = endEven > endOdd ? endEven : endOdd;
  if (need > ws_size) { fprintf(stderr, "workspace too small: need %zu have %zu\n", need, ws_size); return; }

#if COOP
  static int grid_blocks = 0;
  if (!grid_blocks) {
    int dev = 0, cus = 0, per_cu = 0;
    hipGetDevice(&dev);
    hipDeviceGetAttribute(&cus, hipDeviceAttributeMultiprocessorCount, dev);
    hipFuncSetAttribute((const void*)mega, hipFuncAttributeMaxDynamicSharedMemorySize, SMEM_BYTES);
    hipOccupancyMaxActiveBlocksPerMultiprocessor(&per_cu, mega, 512, SMEM_BYTES);
    if (per_cu > 1) per_cu = 1;
    if (per_cu < 1) per_cu = 1;
    grid_blocks = cus * per_cu;
  }
  hipMemsetAsync(p.xbar, 0, (size_t)XCD_BAR_WORDS * 4, stream);
  int pb = 0, pe = NPHASE;
  void* args[] = {&p, &pb, &pe};
  hipError_t e = hipLaunchCooperativeKernel((void*)mega, dim3(grid_blocks), dim3(512), args, SMEM_BYTES, stream);
  if (e != hipSuccess) fprintf(stderr, "cooperative launch failed: %s (grid %d)\n", hipGetErrorString(e), grid_blocks);
#else
  for (int ph = 0; ph < NPHASE; ++ph) mega<<<256, 512, SMEM_BYTES, stream>>>(p, ph, ph + 1);
#endif
}
```
